# Optimizing an MI355X kernel written in HIP

```python
import jax, jax.numpy as jnp
from jax import lax
import numpy as np

D_MODEL = 1024
BATCH = 4
SEQ = 8192
DEPTH = 2

GRID_W = 64
MEM_LEN = 256
EPS = 1e-6

NA_HEADS = 8
NA_HEAD_DIM = 64
NA_WIN_H_MAX = 8
NA_WIN_W = 16
NA_WIDTH = NA_HEADS * NA_HEAD_DIM

MLA_HEADS = 8
MLA_Q_RANK = 384
MLA_KV_RANK = 256
MLA_NOPE = 64
MLA_ROPE = 32
MLA_V = 64
MLA_QK = MLA_NOPE + MLA_ROPE
MLA_WIDTH = MLA_HEADS * MLA_V
MLA_Q_BLOCK = 128
ROPE_BASE = 10000.0
ROPE_AXIS_FREQS = MLA_ROPE // 4

MIX_WIDTH = NA_WIDTH + MLA_WIDTH
IN_COLS = 3 * NA_WIDTH + MLA_Q_RANK + MLA_KV_RANK + MLA_ROPE

MEM_HEADS = 4
MEM_HEAD_DIM = 128
MEM_WIDTH = MEM_HEADS * MEM_HEAD_DIM

D_FF = 2816
CONV_W = 3

kernel_name = "hybrid_natten_mla_memory_convffn_encoder"


def _rmsnorm(x, g):
    xf = x.astype(jnp.float32)
    y = xf * lax.rsqrt(jnp.mean(xf * xf, axis=-1, keepdims=True) + EPS)
    return (y * g.astype(jnp.float32)).astype(x.dtype)


def _rope_tables(seq):
    t = jnp.arange(seq)
    row = (t // GRID_W).astype(jnp.float32)
    col = (t % GRID_W).astype(jnp.float32)
    inv = 1.0 / (ROPE_BASE ** (jnp.arange(ROPE_AXIS_FREQS, dtype=jnp.float32) / ROPE_AXIS_FREQS))
    ang = jnp.concatenate([row[:, None] * inv, col[:, None] * inv], axis=-1)
    return jnp.cos(ang), jnp.sin(ang)


def _rope(x, cos, sin):
    half = x.shape[-1] // 2
    x1, x2 = x[..., :half], x[..., half:]
    c = cos[None, :, None, :].astype(x.dtype)
    s = sin[None, :, None, :].astype(x.dtype)
    return jnp.concatenate([x1 * c - x2 * s, x2 * c + x1 * s], axis=-1)


def _neighbourhood_attention(q, k, v, rpb):
    B, S, H, dh = q.shape
    rows = S // GRID_W
    kh = min(NA_WIN_H_MAX, rows)
    kw = NA_WIN_W
    qg = q.reshape(B, rows, GRID_W, H, dh)
    kg = k.reshape(B, rows, GRID_W, H, dh)
    vg = v.reshape(B, rows, GRID_W, H, dh)
    cq = jnp.arange(GRID_W)
    c0 = jnp.clip(cq - kw // 2, 0, GRID_W - kw)
    col_idx = c0[:, None] + jnp.arange(kw)[None, :]
    dc_idx = col_idx - cq[:, None] + (NA_WIN_W - 1)
    r0 = jnp.clip(jnp.arange(rows) - kh // 2, 0, rows - kh)
    scale = dh ** -0.5

    def row_step(r):
        start = r0[r]
        q_r = lax.dynamic_index_in_dim(qg, r, axis=1, keepdims=False)
        k_band = lax.dynamic_slice_in_dim(kg, start, kh, axis=1)
        v_band = lax.dynamic_slice_in_dim(vg, start, kh, axis=1)
        k_win = k_band[:, :, col_idx]
        v_win = v_band[:, :, col_idx]
        s = jnp.einsum('bqhd,bjqwhd->bhqjw', q_r, k_win).astype(jnp.float32) * scale
        dr_idx = start + jnp.arange(kh) - r + (NA_WIN_H_MAX - 1)
        bias = rpb[:, dr_idx[None, :, None], dc_idx[:, None, :]]
        s = s + bias[None].astype(jnp.float32)
        p = jax.nn.softmax(s.reshape(B, H, GRID_W, kh * kw), axis=-1)
        p = p.reshape(B, H, GRID_W, kh, kw).astype(v.dtype)
        return jnp.einsum('bhqjw,bjqwhd->bqhd', p, v_win)

    o = lax.map(row_step, jnp.arange(rows))
    return o.transpose(1, 0, 2, 3, 4).reshape(B, S, H * dh)


def _dense_attention_blocks(q, k, v):
    B, S, H, dq = q.shape
    dv = v.shape[-1]
    nb = S // MLA_Q_BLOCK
    qb = q.reshape(B, nb, MLA_Q_BLOCK, H, dq).transpose(1, 0, 2, 3, 4)
    scale = dq ** -0.5

    def block(qi):
        s = jnp.einsum('bqhd,bkhd->bhqk', qi, k).astype(jnp.float32) * scale
        p = jax.nn.softmax(s, axis=-1).astype(v.dtype)
        return jnp.einsum('bhqk,bkhd->bqhd', p, v)

    o = lax.map(block, qb)
    return o.transpose(1, 0, 2, 3, 4).reshape(B, S, H * dv)


def _hybrid_mixer(h, cos, sin, w_in, na_q_g, na_k_g, na_rpb, q_lat_g, kv_lat_g,
                  w_uq, w_ukv, mla_q_g, mla_k_g, grp_out_g, w_out):
    B, S, _ = h.shape
    z = h @ w_in
    o1 = NA_WIDTH
    o2 = 2 * NA_WIDTH
    o3 = 3 * NA_WIDTH
    o4 = o3 + MLA_Q_RANK
    o5 = o4 + MLA_KV_RANK
    q_na, k_na, v_na, c_q, c_kv, k_rope = jnp.split(z, [o1, o2, o3, o4, o5], axis=-1)

    q_na = _rmsnorm(q_na.reshape(B, S, NA_HEADS, NA_HEAD_DIM), na_q_g)
    k_na = _rmsnorm(k_na.reshape(B, S, NA_HEADS, NA_HEAD_DIM), na_k_g)
    v_na = v_na.reshape(B, S, NA_HEADS, NA_HEAD_DIM)
    out_a = _neighbourhood_attention(q_na, k_na, v_na, na_rpb)

    q = (_rmsnorm(c_q, q_lat_g) @ w_uq).reshape(B, S, MLA_HEADS, MLA_QK)
    q = _rmsnorm(q, mla_q_g)
    kv = (_rmsnorm(c_kv, kv_lat_g) @ w_ukv).reshape(B, S, MLA_HEADS, MLA_NOPE + MLA_V)
    k_nope, v = kv[..., :MLA_NOPE], kv[..., MLA_NOPE:]
    k_r = jnp.broadcast_to(k_rope[:, :, None, :], (B, S, MLA_HEADS, MLA_ROPE))
    k = _rmsnorm(jnp.concatenate([k_nope, k_r], axis=-1), mla_k_g)
    q = jnp.concatenate([q[..., :MLA_NOPE], _rope(q[..., MLA_NOPE:], cos, sin)], axis=-1)
    k = jnp.concatenate([k[..., :MLA_NOPE], _rope(k[..., MLA_NOPE:], cos, sin)], axis=-1)
    out_b = _dense_attention_blocks(q, k, v)

    out_a = _rmsnorm(out_a, grp_out_g[:NA_WIDTH])
    out_b = _rmsnorm(out_b, grp_out_g[NA_WIDTH:])
    return jnp.concatenate([out_a, out_b], axis=-1) @ w_out


def _memory_cross_attention(h, mem_n, w_q, w_kv, q_g, k_g, w_o):
    B, S, _ = h.shape
    M = mem_n.shape[1]
    q = _rmsnorm((h @ w_q).reshape(B, S, MEM_HEADS, MEM_HEAD_DIM), q_g)
    kv = mem_n @ w_kv
    k = _rmsnorm(kv[..., :MEM_WIDTH].reshape(B, M, MEM_HEADS, MEM_HEAD_DIM), k_g)
    v = kv[..., MEM_WIDTH:].reshape(B, M, MEM_HEADS, MEM_HEAD_DIM)
    s = jnp.einsum('bshd,bmhd->bhsm', q, k).astype(jnp.float32) * (MEM_HEAD_DIM ** -0.5)
    p = jax.nn.softmax(s, axis=-1).astype(v.dtype)
    o = jnp.einsum('bhsm,bmhd->bshd', p, v).reshape(B, S, MEM_WIDTH)
    return o @ w_o


def _conv_ffn(h, w_up, conv_w, conv_b, w_down):
    u = h @ w_up
    up = jnp.pad(u, ((0, 0), (1, 1), (0, 0)))
    u = up[:, :-2] * conv_w[0] + up[:, 1:-1] * conv_w[1] + up[:, 2:] * conv_w[2] + conv_b
    gate, val = u[..., :D_FF], u[..., D_FF:]
    return (jax.nn.silu(gate) * val) @ w_down


def _w(k, shape, fan_in):
    return jax.random.normal(k, shape, jnp.float32) * (fan_in ** -0.5)


def _g(k, shape):
    return 1.0 + 0.02 * jax.random.normal(k, shape, jnp.float32)


def setup_inputs(seed: int = 0) -> dict:
    key = jax.random.key(seed)
    ks = iter(jax.random.split(key, 32))
    L = DEPTH
    return {
        "x": jax.random.normal(next(ks), (BATCH, SEQ, D_MODEL), jnp.float32),
        "mem": jax.random.normal(next(ks), (BATCH, MEM_LEN, D_MODEL), jnp.float32),
        "mix_norm_g": _g(next(ks), (L, D_MODEL)),
        "w_in": _w(next(ks), (L, D_MODEL, IN_COLS), D_MODEL),
        "na_q_g": _g(next(ks), (L, NA_HEAD_DIM)),
        "na_k_g": _g(next(ks), (L, NA_HEAD_DIM)),
        "na_rpb": 0.02 * jax.random.normal(next(ks), (L, NA_HEADS, 2 * NA_WIN_H_MAX - 1, 2 * NA_WIN_W - 1), jnp.float32),
        "q_lat_g": _g(next(ks), (L, MLA_Q_RANK)),
        "kv_lat_g": _g(next(ks), (L, MLA_KV_RANK)),
        "w_uq": _w(next(ks), (L, MLA_Q_RANK, MLA_HEADS * MLA_QK), MLA_Q_RANK),
        "w_ukv": _w(next(ks), (L, MLA_KV_RANK, MLA_HEADS * (MLA_NOPE + MLA_V)), MLA_KV_RANK),
        "mla_q_g": _g(next(ks), (L, MLA_QK)),
        "mla_k_g": _g(next(ks), (L, MLA_QK)),
        "grp_out_g": _g(next(ks), (L, MIX_WIDTH)),
        "w_out": _w(next(ks), (L, MIX_WIDTH, D_MODEL), MIX_WIDTH),
        "mem_norm_g": _g(next(ks), (L, D_MODEL)),
        "mem_tok_norm_g": _g(next(ks), (L, D_MODEL)),
        "mem_w_q": _w(next(ks), (L, D_MODEL, MEM_WIDTH), D_MODEL),
        "mem_w_kv": _w(next(ks), (L, D_MODEL, 2 * MEM_WIDTH), D_MODEL),
        "mem_q_g": _g(next(ks), (L, MEM_HEAD_DIM)),
        "mem_k_g": _g(next(ks), (L, MEM_HEAD_DIM)),
        "mem_w_o": _w(next(ks), (L, MEM_WIDTH, D_MODEL), MEM_WIDTH),
        "ffn_norm_g": _g(next(ks), (L, D_MODEL)),
        "ffn_w_up": _w(next(ks), (L, D_MODEL, 2 * D_FF), D_MODEL),
        "ffn_conv_w": _w(next(ks), (L, CONV_W, 2 * D_FF), CONV_W),
        "ffn_conv_b": 0.02 * jax.random.normal(next(ks), (L, 2 * D_FF), jnp.float32),
        "ffn_w_down": _w(next(ks), (L, D_FF, D_MODEL), D_FF),
    }


def reference(x, mem, mix_norm_g, w_in, na_q_g, na_k_g, na_rpb, q_lat_g, kv_lat_g,
              w_uq, w_ukv, mla_q_g, mla_k_g, grp_out_g, w_out, mem_norm_g,
              mem_tok_norm_g, mem_w_q, mem_w_kv, mem_q_g, mem_k_g, mem_w_o,
              ffn_norm_g, ffn_w_up, ffn_conv_w, ffn_conv_b, ffn_w_down):
    cos, sin = _rope_tables(x.shape[1])
    for l in range(DEPTH):
        h = _rmsnorm(x, mix_norm_g[l])
        x = x + _hybrid_mixer(h, cos, sin, w_in[l], na_q_g[l], na_k_g[l], na_rpb[l],
                              q_lat_g[l], kv_lat_g[l], w_uq[l], w_ukv[l], mla_q_g[l],
                              mla_k_g[l], grp_out_g[l], w_out[l])
        h = _rmsnorm(x, mem_norm_g[l])
        mem_n = _rmsnorm(mem, mem_tok_norm_g[l])
        x = x + _memory_cross_attention(h, mem_n, mem_w_q[l], mem_w_kv[l], mem_q_g[l],
                                        mem_k_g[l], mem_w_o[l])
        h = _rmsnorm(x, ffn_norm_g[l])
        x = x + _conv_ffn(h, ffn_w_up[l], ffn_conv_w[l], ffn_conv_b[l], ffn_w_down[l])
    return x
```

```cpp
#include <hip/hip_runtime.h>
#include <hip/hip_cooperative_groups.h>
#include <cstdint>
#include <cstdio>
namespace cg = cooperative_groups;

#ifndef MK_PER_PHASE
#define MK_PER_PHASE 0
#endif


#ifndef EN_GEMM
#define EN_GEMM 1
#endif
#ifndef EN_P1
#define EN_P1 1
#endif
#ifndef EN_P2
#define EN_P2 1
#endif
#ifndef EN_ATT
#define EN_ATT 1
#endif
#ifndef EN_MLA
#define EN_MLA 1
#endif
#ifndef EN_NA
#define EN_NA 1
#endif
#ifndef EN_P3
#define EN_P3 1
#endif
#ifndef EN_CROSS
#define EN_CROSS 1
#endif
#ifndef EN_CONV
#define EN_CONV 1
#endif

#ifndef REP_MLA
#define REP_MLA 1
#endif
#ifndef REP_NA
#define REP_NA 1
#endif
#ifndef REP_CROSS
#define REP_CROSS 1
#endif
#ifndef REP_GEMM0
#define REP_GEMM0 1
#endif
#ifndef REP_EW
#define REP_EW 1
#endif
#ifndef REP_SYNC
#define REP_SYNC 1
#endif
#define LAS __attribute__((address_space(3)))
typedef unsigned short bf16_t;
typedef short bf16x8 __attribute__((ext_vector_type(8)));
typedef short s16x4 __attribute__((ext_vector_type(4)));
typedef float f32x4 __attribute__((ext_vector_type(4)));
typedef float f32x16 __attribute__((ext_vector_type(16)));
typedef unsigned u32x4 __attribute__((ext_vector_type(4)));
typedef unsigned u32x2 __attribute__((ext_vector_type(2)));

constexpr int BATCH = 4, SEQ = 8192, DM = 1024, T = BATCH * SEQ, DEPTH = 2;
constexpr int ZC = 2304;
constexpr int IN_COLS = 2208;
constexpr int OFF_QNA = 0, OFF_KNA = 512, OFF_VNA = 1024, OFF_CQ = 1536, OFF_CKV = 1920, OFF_KR = 2176;
constexpr int DFF = 2816, DFF2 = 5632;
constexpr int MEMT = BATCH * 256;
constexpr float EPS = 1e-6f;
constexpr float LOG2E = 1.4426950408889634f;
constexpr int TH = T / 2;

constexpr size_t MiB = 1u << 20;
constexpr size_t WS_TAB = 0;
constexpr size_t WS_BAR = 512 * 1024, BAR_BYTES = 16384;
constexpr size_t WS_W = 1 * MiB;
constexpr size_t W_IN = 0, W_UQ = W_IN + (size_t)ZC * 1024 * 2, W_UKV = W_UQ + (size_t)768 * 384 * 2, W_OUT = W_UKV + (size_t)1024 * 256 * 2,
                 W_MQ = W_OUT + (size_t)1024 * 1024 * 2, W_MKV = W_MQ + (size_t)512 * 1024 * 2, W_MO = W_MKV + (size_t)1024 * 1024 * 2,
                 W_UP = W_MO + (size_t)1024 * 512 * 2, W_DN = W_UP + (size_t)DFF2 * 1024 * 2, W_LAYER = W_DN + (size_t)1024 * DFF * 2;
static_assert(WS_W + 2 * W_LAYER <= 60 * MiB, "weights");
constexpr size_t WS_MEMN = 60 * MiB, WS_KVCR = 64 * MiB, WS_KC = 68 * MiB, WS_VC = 70 * MiB;
constexpr size_t WS_XN = 72 * MiB;
constexpr size_t WS_QA = 72 * MiB;
constexpr size_t WS_Z = 136 * MiB;
constexpr size_t WS_MIX = 328 * MiB;
constexpr size_t WS_QM = 280 * MiB, WS_KVM = 328 * MiB;
constexpr size_t WS_OA = 280 * MiB, WS_OB = 312 * MiB;
constexpr size_t WS_KA = 392 * MiB, WS_VA = 440 * MiB;
constexpr size_t WS_QC = 136 * MiB, WS_OC = 168 * MiB;
constexpr size_t WS_U = 136 * MiB, WS_ACT = 136 * MiB;
constexpr size_t WS_RS = 472 * MiB;
constexpr size_t WS_END = 474 * MiB;

constexpr int LDS_BYTES = 150 * 1024;
constexpr int LDS_MISC = LDS_BYTES - 64;

__device__ __forceinline__ unsigned pk2(float lo, float hi) { unsigned r; asm("v_cvt_pk_bf16_f32 %0, %1, %2" : "=v"(r) : "v"(lo), "v"(hi)); return r; }
__device__ __forceinline__ float bf_lo(unsigned u) { return __uint_as_float(u << 16); }
__device__ __forceinline__ float bf_hi(unsigned u) { return __uint_as_float(u & 0xffff0000u); }
template <int O> __device__ __forceinline__ float xorl(float v) {
    if constexpr (O < 32) return __uint_as_float((unsigned)__builtin_amdgcn_ds_swizzle((int)__float_as_uint(v), (O << 10) | 0x1f));
    else { auto rr = __builtin_amdgcn_permlane32_swap(__float_as_uint(v), __float_as_uint(v), false, false); return __uint_as_float((__float_as_uint(v) == rr[0]) ? rr[1] : rr[0]); }
}
template <int CTRL> __device__ __forceinline__ float dppf(float old, float srcv) {
    return __int_as_float(__builtin_amdgcn_update_dpp(__float_as_int(old), __float_as_int(srcv), CTRL, 0xf, 0xf, false));
}
template <int CTRL> __device__ __forceinline__ f32x4 rot4(f32x4 s) {
    f32x4 r;
#pragma unroll
    for (int e = 0; e < 4; ++e) r[e] = __int_as_float(__builtin_amdgcn_mov_dpp(__float_as_int(s[e]), CTRL, 0xf, 0xf, false));
    return r;
}
template <int CTRL> __device__ __forceinline__ f32x4 dpp4(f32x4 old, f32x4 s) { f32x4 r; r[0] = dppf<CTRL>(old[0], s[0]); r[1] = dppf<CTRL>(old[1], s[1]); r[2] = dppf<CTRL>(old[2], s[2]); r[3] = dppf<CTRL>(old[3], s[3]); return r; }
__device__ __forceinline__ float att_swap_add(float v) {
    auto rr = __builtin_amdgcn_permlane32_swap(__float_as_uint(v), __float_as_uint(v), false, false);
    return __uint_as_float(rr[0]) + __uint_as_float(rr[1]);
}
__device__ __forceinline__ float wave_sum(float v) {
    v += xorl<1>(v); v += xorl<2>(v); v += xorl<4>(v); v += xorl<8>(v); v += xorl<16>(v);
    auto rr = __builtin_amdgcn_permlane32_swap(__float_as_uint(v), __float_as_uint(v), false, false);
    return __uint_as_float(rr[0]) + __uint_as_float(rr[1]);
}
__device__ __forceinline__ float wave_max(float v) {
    v = fmaxf(v, xorl<1>(v)); v = fmaxf(v, xorl<2>(v)); v = fmaxf(v, xorl<4>(v)); v = fmaxf(v, xorl<8>(v)); v = fmaxf(v, xorl<16>(v));
    auto rr = __builtin_amdgcn_permlane32_swap(__float_as_uint(v), __float_as_uint(v), false, false);
    return fmaxf(__uint_as_float(rr[0]), __uint_as_float(rr[1]));
}
__device__ __forceinline__ void unpack8(const u32x4 v, float* f) {
    f[0] = bf_lo(v.x); f[1] = bf_hi(v.x); f[2] = bf_lo(v.y); f[3] = bf_hi(v.y); f[4] = bf_lo(v.z); f[5] = bf_hi(v.z); f[6] = bf_lo(v.w); f[7] = bf_hi(v.w);
}
__device__ __forceinline__ u32x4 pack8(const float* f) { u32x4 o; o.x = pk2(f[0], f[1]); o.y = pk2(f[2], f[3]); o.z = pk2(f[4], f[5]); o.w = pk2(f[6], f[7]); return o; }
__device__ __forceinline__ float sumsq8(const u32x4 v) { float f[8]; unpack8(v, f); float s = 0.f;
#pragma unroll
    for (int e = 0; e < 8; ++e) s += f[e] * f[e];
    return s; }

namespace pg8 {
constexpr int BM = 256, BK = 64, HALF = 128, HTB = HALF * BK * 2, STAGE_BYTES = 8 * HTB, NXCD = 8, WGM = 8;
__host__ __device__ __forceinline__ int lds_byte(int r, int c) { const int st = (r >> 4) * 2 + (c >> 5), rr = r & 15, cc = c & 31, ob = rr * 64 + cc * 2; return st * 1024 + (ob ^ (((ob >> 9) & 1) << 5)); }
__host__ __device__ __forceinline__ void stage_rc(int b, int& R, int& C) { const int st = b / 1024, sb = b % 1024, swz = sb ^ (((sb >> 9) & 1) << 5); R = (st >> 1) * 16 + swz / 64; C = (st & 1) * 32 + (swz % 64) / 2; }
__host__ __device__ __forceinline__ int perm32(int rho) { const int n = rho >> 4, i = rho & 15; return 8 * (i >> 2) + 4 * n + (i & 3); }

__device__ __forceinline__ const char* uniform_cptr(const char* p) {
    const unsigned long long v = (unsigned long long)p;
    const unsigned lo = __builtin_amdgcn_readfirstlane((unsigned)v), hi = __builtin_amdgcn_readfirstlane((unsigned)(v >> 32));
    return (const char*)(((unsigned long long)hi << 32) | lo);
}
struct Unit { int pm, pn; };
struct Gemm { const bf16_t* A; const bf16_t* Bt; int M, N, K, lda; const float* mida; const float* midb; int trows, pad_; };

struct StaticOrder {
    int nM, nN, nwg, G, c;
    __device__ void init(int M, int N, int G_, int c_) { nM = M / BM; nN = N / BM; nwg = nM * nN; G = G_; c = c_; }
    __device__ bool next(int i, Unit& u) const {
        const long L = (long)i * G + c; if (L >= nwg) return false;
        int wgid = (int)L; { const int q = nwg / NXCD, r = nwg % NXCD, xcd = wgid % NXCD, off = wgid / NXCD; wgid = (xcd < r ? xcd * (q + 1) : r * (q + 1) + (xcd - r) * q) + off; }
        const int nig = WGM * nN, gid = wgid / nig, fm = gid * WGM, gsz = (nM - fm) < WGM ? (nM - fm) : WGM;
        u.pm = fm + ((wgid % nig) % gsz); u.pn = (wgid % nig) / gsz; return true;
    }
};

struct EpiDesc { int mode, ldc; void* dst; const float* base; float* rs; bf16_t* xb; const float* rs2; };
#define GAS __attribute__((address_space(1)))
struct EpiUni {
    static constexpr bool PERM = true, PREFETCH_RS = true;
    const LAS EpiDesc* d;
    __device__ __forceinline__ void operator()(f32x4 (&acc)[2][2][4][2], const Unit& u, int wr, int wc, int fr, int fq, const float (&rsv)[8]) const {
        const int mode = __builtin_amdgcn_readfirstlane(d->mode), ldc = __builtin_amdgcn_readfirstlane(d->ldc);
        GAS float* const rs = (GAS float*)d->rs;
        const int row0 = u.pm * BM + wr * 64 + fr; const int col0 = u.pn * BM + wc * 32 + 8 * fq;
        if (mode == 0) {
            GAS bf16_t* const O = (GAS bf16_t*)d->dst;
            float sc[2][4];
#pragma unroll
            for (int ai = 0; ai < 2; ++ai)
#pragma unroll
                for (int m = 0; m < 4; ++m) sc[ai][m] = rsv[ai * 4 + m];
            if (rs) {
#pragma unroll
                for (int ai = 0; ai < 2; ++ai)
#pragma unroll
                    for (int m = 0; m < 4; ++m) sc[ai][m] = __builtin_amdgcn_rsqf(sc[ai][m] * (1.0f / 1024.0f) + EPS);
            } else {
#pragma unroll
                for (int ai = 0; ai < 2; ++ai)
#pragma unroll
                    for (int m = 0; m < 4; ++m) sc[ai][m] = 1.0f;
            }
#pragma unroll
            for (int ai = 0; ai < 2; ++ai)
#pragma unroll
                for (int m = 0; m < 4; ++m) { const int row = row0 + ai * HALF + m * 16; GAS bf16_t* rowp = O + (size_t)row * ldc + col0;
#pragma unroll
                    for (int bj = 0; bj < 2; ++bj) { const f32x4 v0 = acc[ai][bj][m][0] * sc[ai][m], v1 = acc[ai][bj][m][1] * sc[ai][m];
                        u32x4 w; w.x = pk2(v0[0], v0[1]); w.y = pk2(v0[2], v0[3]); w.z = pk2(v1[0], v1[1]); w.w = pk2(v1[2], v1[3]);
                        *(GAS u32x4*)(rowp + bj * HALF) = w; } }
        } else {
            GAS float* const out = (GAS float*)d->dst; const GAS float* const base = (const GAS float*)d->base; GAS bf16_t* const xb = (GAS bf16_t*)d->xb; const GAS float* const rs2 = (const GAS float*)d->rs2;
#pragma unroll
            for (int ab = 0; ab < 4; ++ab) { const int ai = ab >> 1, mb = (ab & 1) * 2;
                f32x4 pre[2][2][2];
#pragma unroll
                for (int mm = 0; mm < 2; ++mm) { const size_t off = (size_t)(row0 + ai * HALF + (mb + mm) * 16) * ldc + col0;
#pragma unroll
                    for (int bj = 0; bj < 2; ++bj) { pre[mm][bj][0] = *(const GAS f32x4*)(base + off + bj * HALF); pre[mm][bj][1] = *(const GAS f32x4*)(base + off + bj * HALF + 4); } }
#pragma unroll
                for (int mm = 0; mm < 2; ++mm) { const int m = mb + mm; const int row = row0 + ai * HALF + m * 16; const size_t off = (size_t)row * ldc + col0; float ss = 0.f;
                    float s2 = 1.0f; if (rs2) s2 = __builtin_amdgcn_rsqf(rs2[row] * (1.0f / 512.0f) + EPS);
#pragma unroll
                    for (int bj = 0; bj < 2; ++bj) {
                        const f32x4 o0 = pre[mm][bj][0] + acc[ai][bj][m][0] * s2, o1 = pre[mm][bj][1] + acc[ai][bj][m][1] * s2;
                        *(GAS f32x4*)(out + off + bj * HALF) = o0; *(GAS f32x4*)(out + off + bj * HALF + 4) = o1;
                        if (xb) { u32x4 w; w.x = pk2(o0[0], o0[1]); w.y = pk2(o0[2], o0[3]); w.z = pk2(o1[0], o1[1]); w.w = pk2(o1[2], o1[3]); *(GAS u32x4*)(xb + off + bj * HALF) = w;
                            ss += (o0[0] * o0[0] + o0[1] * o0[1]) + (o0[2] * o0[2] + o0[3] * o0[3]) + (o1[0] * o1[0] + o1[1] * o1[1]) + (o1[2] * o1[2] + o1[3] * o1[3]); } }
                    if (xb) { ss += xorl<16>(ss); ss = att_swap_add(ss); if (fq == 0) __builtin_amdgcn_global_atomic_fadd_f32(rs + row, ss); } }
                asm volatile("" ::: "memory");
            }
        }
    }
};

struct EpiConv {
    static constexpr bool PERM = true, PREFETCH_RS = false;
    const LAS EpiDesc* d;
    __device__ __forceinline__ void operator()(f32x4 (&acc)[2][2][4][2], const Unit& u, int wr, int wc, int fr, int fq, const float (&rsv)[8]) const {
            GAS bf16_t* const ACTp = (GAS bf16_t*)d->dst; const GAS float* const cw = (const GAS float*)d->base; const GAS float* const cbp = (const GAS float*)d->rs2;
            const int tr0 = wr * 64 + fr; const int t0 = u.pm * 254 - 1 + tr0;
            const int w8 = wr * 4 + wc;
            float cwv[2];
#pragma unroll
            for (int k = 0; k < 2; ++k) { const int idx = w8 * 64 + fq * 16 + fr + 512 * k, bjx = idx >> 9, arr = (idx >> 7) & 3, col = idx & 127;
                const GAS float* sp_ = ((arr < 3) ? (cw + arr * DFF2) : cbp) + bjx * DFF + u.pn * 128 + col; cwv[k] = *sp_; }
#pragma unroll
            for (int ai = 0; ai < 2; ++ai)
#pragma unroll
                for (int m = 0; m < 4; ++m) { const float sc = __builtin_amdgcn_rsqf(rsv[ai * 4 + m] * (1.0f / 1024.0f) + EPS);
#pragma unroll
                    for (int bj = 0; bj < 2; ++bj)
#pragma unroll
                        for (int n = 0; n < 2; ++n) acc[ai][bj][m][n] = acc[ai][bj][m][n] * sc; }
            LAS float* const xch = (LAS float*)((LAS unsigned char*)d + 768);
            if (fr == 0) {
#pragma unroll
                for (int ai = 0; ai < 2; ++ai)
#pragma unroll
                    for (int bj = 0; bj < 2; ++bj) { LAS f32x4* p = (LAS f32x4*)(xch + ((((w8 * 2 + ai) * 2 + 0) * 2 + bj) * 4 + fq) * 8); p[0] = acc[ai][bj][0][0]; p[1] = acc[ai][bj][0][1]; }
            }
            if (fr == 15) {
#pragma unroll
                for (int ai = 0; ai < 2; ++ai)
#pragma unroll
                    for (int bj = 0; bj < 2; ++bj) { LAS f32x4* p = (LAS f32x4*)(xch + ((((w8 * 2 + ai) * 2 + 1) * 2 + bj) * 4 + fq) * 8); p[0] = acc[ai][bj][3][0]; p[1] = acc[ai][bj][3][1]; }
            }
            LAS float* const cwl = xch + 2048;
#pragma unroll
            for (int k = 0; k < 2; ++k) cwl[w8 * 64 + fq * 16 + fr + 512 * k] = cwv[k];
            asm volatile("s_waitcnt lgkmcnt(0)" ::: "memory"); __builtin_amdgcn_s_barrier(); asm volatile("" ::: "memory");
            const int colg = u.pn * 128 + wc * 32 + fq * 8; const int cl = wc * 32 + fq * 8;
#pragma unroll
            for (int n = 0; n < 2; ++n) {
                const int c4 = colg + 4 * n;
                const LAS f32x4* const wlg = (const LAS f32x4*)(cwl + cl + 4 * n); const LAS f32x4* const wlv = (const LAS f32x4*)(cwl + 512 + cl + 4 * n);
                const f32x4 w0g = wlg[0], w1g = wlg[32], w2g = wlg[64], bg = wlg[96], w0v = wlv[0], w1v = wlv[32], w2v = wlv[64], bv = wlv[96];
#pragma unroll
                for (int ai = 0; ai < 2; ++ai) {
                    const int pw = (wr == 1) ? wc : ((ai == 1) ? 4 + wc : -1), pai = (wr == 1) ? ai : 0;
                    const int nw = (wr == 0) ? 4 + wc : ((ai == 0) ? wc : -1), nai = (wr == 0) ? ai : 1;
                    f32x4 pHg = (f32x4){0.f, 0.f, 0.f, 0.f}, pHv = pHg, nHg = pHg, nHv = pHg;
                    if (pw >= 0) { pHg = *(const LAS f32x4*)(xch + ((((pw * 2 + pai) * 2 + 1) * 2 + 0) * 4 + fq) * 8 + 4 * n); pHv = *(const LAS f32x4*)(xch + ((((pw * 2 + pai) * 2 + 1) * 2 + 1) * 4 + fq) * 8 + 4 * n); }
                    if (nw >= 0) { nHg = *(const LAS f32x4*)(xch + ((((nw * 2 + nai) * 2 + 0) * 2 + 0) * 4 + fq) * 8 + 4 * n); nHv = *(const LAS f32x4*)(xch + ((((nw * 2 + nai) * 2 + 0) * 2 + 1) * 4 + fq) * 8 + 4 * n); }
#pragma unroll
                    for (int m = 0; m < 4; ++m) {
                        const int t = t0 + ai * HALF + m * 16, rho = tr0 + ai * HALF + m * 16, sp = t & (SEQ - 1);
                        int spl = sp; asm volatile("" : "+v"(spl));
                        const float mp = (spl == 0) ? 0.f : 1.f, mn = (spl == SEQ - 1) ? 0.f : 1.f;
                        float o[4];
                        {
                            const f32x4 cg = acc[ai][0][m][n];
                            const f32x4 fp = (m == 0) ? pHg : rot4<0x121>(acc[ai][0][m == 0 ? 0 : m - 1][n]);
                            const f32x4 fn = (m == 3) ? nHg : rot4<0x12F>(acc[ai][0][m == 3 ? 3 : m + 1][n]);
                            const f32x4 pg = dpp4<0x111>(fp, cg), ng = dpp4<0x101>(fn, cg);
                            const f32x4 gt = (pg * w0g) * mp + cg * w1g + (ng * w2g) * mn + bg;
#pragma unroll
                            for (int e = 0; e < 4; ++e) o[e] = gt[e] * __builtin_amdgcn_rcpf(1.0f + __builtin_amdgcn_exp2f(-1.4426950408889634f * gt[e]));
                        }
                        __builtin_amdgcn_sched_barrier(0);
                        {
                            const f32x4 cv = acc[ai][1][m][n];
                            const f32x4 fp = (m == 0) ? pHv : rot4<0x121>(acc[ai][1][m == 0 ? 0 : m - 1][n]);
                            const f32x4 fn = (m == 3) ? nHv : rot4<0x12F>(acc[ai][1][m == 3 ? 3 : m + 1][n]);
                            const f32x4 pv = dpp4<0x111>(fp, cv), nv = dpp4<0x101>(fn, cv);
                            const f32x4 vl = (pv * w0v) * mp + cv * w1v + (nv * w2v) * mn + bv;
#pragma unroll
                            for (int e = 0; e < 4; ++e) o[e] *= vl[e];
                        }
                        if (rho >= 1 && rho <= 254 && t < T) { u32x2 w; w.x = pk2(o[0], o[1]); w.y = pk2(o[2], o[3]); *(GAS u32x2*)(ACTp + (size_t)t * DFF + c4) = w; }
                        __builtin_amdgcn_sched_barrier(0);
                    }
                }
            }
    }
};

template <class Epi, class Sched>
__device__ __forceinline__ void gemm_phase(LAS unsigned char* lds, const LAS Gemm* gd, const Sched& S, const Epi& E, const int wid) {
    int lane; asm volatile("v_mbcnt_lo_u32_b32 %0, -1, 0\n\tv_mbcnt_hi_u32_b32 %0, -1, %0" : "=v"(lane));
    const int tid = wid * 64 + lane, wr = wid >> 2, wc = wid & 3, fr = lane & 15, fq = lane >> 4;
    const int K = __builtin_amdgcn_readfirstlane(gd->K), nt = K / BK, lda = __builtin_amdgcn_readfirstlane(gd->lda);
#define GD_A (uniform_cptr((const char*)gd->A))
#define GD_B (uniform_cptr((const char*)gd->Bt))
    unsigned voffA[2], voffB[2];
#pragma unroll
    for (int i = 0; i < 2; ++i) { int R, C; stage_rc(tid * 16 + i * 8192, R, C); const int Rb = Epi::PERM ? ((R & ~31) + perm32(R & 31)) : R;
        voffA[i] = (unsigned)(R * lda + C) * 2u; voffB[i] = (unsigned)(Rb * K + C) * 2u; }
    constexpr unsigned kstep = BK * 2;
    const unsigned hstepA = (unsigned)HALF * lda * 2, hstepB = (unsigned)HALF * K * 2;
    const int trows = __builtin_amdgcn_readfirstlane(gd->trows);
    const unsigned tstepA = (unsigned)trows * lda * 2, tstepB = 2 * hstepB;
    const unsigned ldsw = (unsigned)wid * 1024u;
    const int aoff = lds_byte(wr * 64 + fr, fq * 8), boff = lds_byte(wc * 32 + fr, fq * 8);
#define PG8_SA(b, h) (((b) * 2 + (h)) * HTB)
#define PG8_SB(b, h) ((4 + (b) * 2 + (h)) * HTB)
#define PG8_STAGE(bufoff, gbase, voff) do { _Pragma("unroll") for (int _i = 0; _i < 2; ++_i) \
        __builtin_amdgcn_global_load_lds((const unsigned*)((const char*)(gbase) + (voff)[_i]), (LAS unsigned*)(lds + (bufoff) + ldsw + _i * 8192), 16, 0, 0); } while (0)
#define PG8_LDA(dst, b, h) do { _Pragma("unroll") for (int m = 0; m < 4; ++m) _Pragma("unroll") for (int k = 0; k < 2; ++k) dst[m][k] = *(const LAS bf16x8*)(lds + PG8_SA(b, h) + aoff + m * 2048 + k * 1024); } while (0)
#define PG8_LDB(dst, b, h) do { _Pragma("unroll") for (int n = 0; n < 2; ++n) _Pragma("unroll") for (int k = 0; k < 2; ++k) dst[n][k] = *(const LAS bf16x8*)(lds + PG8_SB(b, h) + boff + n * 2048 + k * 1024); } while (0)
#define PG8_MMA(ai, bj, At, Bt) do { __builtin_amdgcn_s_setprio(1); _Pragma("unroll") for (int m = 0; m < 4; ++m) _Pragma("unroll") for (int n = 0; n < 2; ++n) _Pragma("unroll") for (int k = 0; k < 2; ++k) \
        acc[ai][bj][m][n] = __builtin_amdgcn_mfma_f32_16x16x32_bf16(Bt[n][k], At[m][k], acc[ai][bj][m][n], 0, 0, 0); __builtin_amdgcn_s_setprio(0); } while (0)
#define PG8_WAIT_V(n) asm volatile("s_waitcnt vmcnt(" #n ")" ::: "memory")
#define PG8_WAIT_L(n) asm volatile("s_waitcnt lgkmcnt(" #n ")" ::: "memory")
#define PG8_BAR __builtin_amdgcn_s_barrier()
#define PG8_SCHED __builtin_amdgcn_sched_barrier(0)
    Unit cur, nxt; int ui = 0;
    if (!S.next(0, cur)) return;
    const GAS float* const rsp = (E.d->mode != 1) ? (const GAS float*)uniform_cptr((const char*)E.d->rs) : nullptr;
    float rsv[8];
#pragma unroll
    for (int q = 0; q < 8; ++q) rsv[q] = 1024.0f;
    f32x4 acc[2][2][4][2];
#pragma unroll
    for (int a = 0; a < 2; ++a)
#pragma unroll
        for (int b = 0; b < 2; ++b)
#pragma unroll
            for (int m = 0; m < 4; ++m)
#pragma unroll
                for (int n = 0; n < 2; ++n) acc[a][b][m][n] = (f32x4){0.f, 0.f, 0.f, 0.f};
    bf16x8 At[4][2], B0[2][2], B1[2][2];
    const char* cA = GD_A + (unsigned)cur.pm * tstepA; const char* cB = GD_B + (unsigned)cur.pn * tstepB;
    PG8_STAGE(PG8_SB(0, 0), cB, voffB); PG8_STAGE(PG8_SB(0, 1), cB + hstepB, voffB); PG8_STAGE(PG8_SA(0, 0), cA, voffA); PG8_STAGE(PG8_SA(0, 1), cA + hstepA, voffA);
    if (wr == 1) PG8_BAR;
    PG8_WAIT_V(2); PG8_BAR;
    PG8_STAGE(PG8_SB(1, 0), cB + kstep, voffB); PG8_STAGE(PG8_SA(1, 0), cA + kstep, voffA); PG8_STAGE(PG8_SB(1, 1), cB + hstepB + kstep, voffB);
    PG8_WAIT_V(6); PG8_BAR;
    for (;;) {
        const bool has_next = S.next(ui + 1, nxt);
        const char* nA = has_next ? GD_A + (unsigned)nxt.pm * tstepA : cA; const char* nB = has_next ? GD_B + (unsigned)nxt.pn * tstepB : cB;
        for (int t = 0; t < nt; t += 2) {
            if (t == (nt >> 1) && gd->mida != nullptr) {
                const int rbase = cur.pm * BM + wr * 64 + fr;
#pragma unroll
                for (int a = 0; a < 2; ++a)
#pragma unroll
                    for (int m = 0; m < 4; ++m) { const int row = rbase + a * HALF + m * 16;
                        const float qa = ((const GAS float*)uniform_cptr((const char*)gd->mida))[row], qb = ((const GAS float*)uniform_cptr((const char*)gd->midb))[row];
                        const float ratio = sqrtf((qb * (1.0f / 512.0f) + EPS) / (qa * (1.0f / 512.0f) + EPS));
#pragma unroll
                        for (int b = 0; b < 2; ++b)
#pragma unroll
                            for (int n = 0; n < 2; ++n) acc[a][b][m][n] = acc[a][b][m][n] * ratio; }
            }
            const bool last = (t == nt - 2);
            if (Epi::PREFETCH_RS && last && rsp != nullptr) {
                const int rb = cur.pm * trows + (trows == 254 ? -1 : 0) + wr * 64 + fr;
#pragma unroll
                for (int q = 0; q < 8; ++q) rsv[q] = rsp[rb + (q >> 2) * HALF + (q & 3) * 16];
            }
            const char* a1 = cA + (unsigned)(t + 1) * kstep;
            const char* a2 = last ? nA : cA + (unsigned)(t + 2) * kstep; const char* b2 = last ? nB : cB + (unsigned)(t + 2) * kstep;
            const char* a3 = a2 + kstep; const char* b3 = b2 + kstep;
            PG8_LDB(B0, 0, 0); PG8_LDB(B1, 0, 1); PG8_SCHED; PG8_LDA(At, 0, 0); PG8_STAGE(PG8_SA(1, 1), a1 + hstepA, voffA);
            PG8_WAIT_V(8); PG8_WAIT_L(0); PG8_BAR; PG8_MMA(0, 0, At, B0); PG8_MMA(0, 1, At, B1); PG8_BAR; PG8_SCHED;
            PG8_LDA(At, 0, 1); PG8_STAGE(PG8_SB(0, 0), b2, voffB); PG8_STAGE(PG8_SB(0, 1), b2 + hstepB, voffB); PG8_STAGE(PG8_SA(0, 0), a2, voffA);
            PG8_WAIT_V(8); PG8_WAIT_L(0); PG8_BAR; PG8_MMA(1, 0, At, B0); PG8_MMA(1, 1, At, B1); PG8_BAR; PG8_SCHED;
            PG8_LDB(B0, 1, 0); PG8_LDB(B1, 1, 1); PG8_SCHED; PG8_LDA(At, 1, 0); PG8_STAGE(PG8_SA(0, 1), a2 + hstepA, voffA);
            PG8_WAIT_V(8); PG8_WAIT_L(0); PG8_BAR; PG8_MMA(0, 0, At, B0); PG8_MMA(0, 1, At, B1); PG8_BAR; PG8_SCHED;
            PG8_LDA(At, 1, 1); PG8_STAGE(PG8_SB(1, 0), b3, voffB); PG8_STAGE(PG8_SB(1, 1), b3 + hstepB, voffB); PG8_STAGE(PG8_SA(1, 0), a3, voffA);
            PG8_WAIT_V(8); PG8_WAIT_L(0); PG8_BAR; PG8_MMA(1, 0, At, B0); PG8_MMA(1, 1, At, B1); PG8_BAR; PG8_SCHED;
        }
        if (wr == 0) PG8_BAR;
        if constexpr (Epi::PREFETCH_RS) { E(acc, cur, wr, wc, fr, fq, rsv); }
        else { float rl[8]; const int rb = cur.pm * trows + (trows == 254 ? -1 : 0) + wr * 64 + fr;
#pragma unroll
            for (int q = 0; q < 8; ++q) rl[q] = rsp[rb + (q >> 2) * HALF + (q & 3) * 16];
            E(acc, cur, wr, wc, fr, fq, rl); }
        if (!has_next) break;
#pragma unroll
        for (int a = 0; a < 2; ++a)
#pragma unroll
            for (int b = 0; b < 2; ++b)
#pragma unroll
                for (int m = 0; m < 4; ++m)
#pragma unroll
                    for (int n = 0; n < 2; ++n) acc[a][b][m][n] = (f32x4){0.f, 0.f, 0.f, 0.f};
        cur = nxt; cA = nA; cB = nB; ++ui;
        if (wr == 1) PG8_BAR;
    }
    PG8_WAIT_V(0);
    PG8_BAR;
#undef GD_A
#undef GD_B
#undef PG8_SA
#undef PG8_SB
#undef PG8_STAGE
#undef PG8_LDA
#undef PG8_LDB
#undef PG8_MMA
#undef PG8_WAIT_V
#undef PG8_WAIT_L
#undef PG8_BAR
#undef PG8_SCHED
}
}

namespace att {
#define KSWZ(row, colB) ((row) * 256 + ((colB) ^ (((row) & 7) << 4)))
#define SBAR() __builtin_amdgcn_sched_barrier(0)
__device__ __forceinline__ int crow(int r, int hi) { return (r & 3) + 8 * (r >> 2) + 4 * hi; }
template <int NDV> __device__ __forceinline__ int v_st(int k, int c) { const int kk = (k & ~0xC) | ((k & 4) << 1) | ((k & 8) >> 1); return ((kk >> 3) * NDV + (c >> 5)) * 512 + ((kk & 7) * 32 + (c & 31)) * 2; }
__device__ __forceinline__ int v_rd_base(int lane) { return ((lane & 3) << 3) | (((lane >> 2) & 3) << 6) | (((lane >> 4) & 1) << 5) | (((lane >> 5) & 1) << 8); }
template <int OFF> __device__ __forceinline__ s16x4 tr_read(int vb) {
    s16x4 r; asm volatile("ds_read_b64_tr_b16 %0, %1 offset:%2" : "=&v"(r) : "v"(vb), "i"(OFF) : "memory"); return r;
}
template <int NDV, int D0> __device__ __forceinline__ void pv_one(f32x16& od, int vb, bf16x8 pa0, bf16x8 pa1, bf16x8 pa2, bf16x8 pa3) {
    constexpr int KS = 2 * NDV * 512, HF = NDV * 512, B0 = D0 * 512;
    const s16x4 l0 = tr_read<B0>(vb), h0 = tr_read<B0 + HF>(vb), l1 = tr_read<B0 + KS>(vb), h1 = tr_read<B0 + KS + HF>(vb);
    const s16x4 l2 = tr_read<B0 + 2 * KS>(vb), h2 = tr_read<B0 + 2 * KS + HF>(vb), l3 = tr_read<B0 + 3 * KS>(vb), h3 = tr_read<B0 + 3 * KS + HF>(vb);
    asm volatile("s_waitcnt lgkmcnt(0)" ::: "memory"); SBAR();
#define PK(L, H) (bf16x8){L[0], L[1], L[2], L[3], H[0], H[1], H[2], H[3]}
    od = __builtin_amdgcn_mfma_f32_32x32x16_bf16(pa0, PK(l0, h0), od, 0, 0, 0);
    od = __builtin_amdgcn_mfma_f32_32x32x16_bf16(pa1, PK(l1, h1), od, 0, 0, 0);
    od = __builtin_amdgcn_mfma_f32_32x32x16_bf16(pa2, PK(l2, h2), od, 0, 0, 0);
    od = __builtin_amdgcn_mfma_f32_32x32x16_bf16(pa3, PK(l3, h3), od, 0, 0, 0);
#undef PK
}
template <int NDV> __device__ __forceinline__ void pv_all(f32x16* o, int vb, bf16x8 pa0, bf16x8 pa1, bf16x8 pa2, bf16x8 pa3) {
    if constexpr (NDV == 2) {
        constexpr int KS = 2 * NDV * 512, HF = NDV * 512;
        const s16x4 l0 = tr_read<0>(vb), h0 = tr_read<HF>(vb), m0 = tr_read<512>(vb), n0 = tr_read<512 + HF>(vb);
        const s16x4 l1 = tr_read<KS>(vb), h1 = tr_read<KS + HF>(vb), m1 = tr_read<KS + 512>(vb), n1 = tr_read<KS + 512 + HF>(vb);
        const s16x4 l2 = tr_read<2 * KS>(vb), h2 = tr_read<2 * KS + HF>(vb), m2 = tr_read<2 * KS + 512>(vb), n2 = tr_read<2 * KS + 512 + HF>(vb);
        const s16x4 l3 = tr_read<3 * KS>(vb), h3 = tr_read<3 * KS + HF>(vb), m3 = tr_read<3 * KS + 512>(vb), n3 = tr_read<3 * KS + 512 + HF>(vb);
        asm volatile("s_waitcnt lgkmcnt(0)" ::: "memory"); SBAR();
#define PK(L, H) (bf16x8){L[0], L[1], L[2], L[3], H[0], H[1], H[2], H[3]}
        o[0] = __builtin_amdgcn_mfma_f32_32x32x16_bf16(pa0, PK(l0, h0), o[0], 0, 0, 0); o[1] = __builtin_amdgcn_mfma_f32_32x32x16_bf16(pa0, PK(m0, n0), o[1], 0, 0, 0);
        o[0] = __builtin_amdgcn_mfma_f32_32x32x16_bf16(pa1, PK(l1, h1), o[0], 0, 0, 0); o[1] = __builtin_amdgcn_mfma_f32_32x32x16_bf16(pa1, PK(m1, n1), o[1], 0, 0, 0);
        o[0] = __builtin_amdgcn_mfma_f32_32x32x16_bf16(pa2, PK(l2, h2), o[0], 0, 0, 0); o[1] = __builtin_amdgcn_mfma_f32_32x32x16_bf16(pa2, PK(m2, n2), o[1], 0, 0, 0);
        o[0] = __builtin_amdgcn_mfma_f32_32x32x16_bf16(pa3, PK(l3, h3), o[0], 0, 0, 0); o[1] = __builtin_amdgcn_mfma_f32_32x32x16_bf16(pa3, PK(m3, n3), o[1], 0, 0, 0);
#undef PK
    } else {
        pv_one<NDV, 0>(o[0], vb, pa0, pa1, pa2, pa3); pv_one<NDV, 1>(o[1], vb, pa0, pa1, pa2, pa3);
        pv_one<NDV, 2>(o[2], vb, pa0, pa1, pa2, pa3); pv_one<NDV, 3>(o[3], vb, pa0, pa1, pa2, pa3);
    }
}
__device__ __forceinline__ void pack_p(const f32x16& p0, const f32x16& p1, bf16x8& pa0, bf16x8& pa1, bf16x8& pa2, bf16x8& pa3) {
#define PK4(P, BASE, OUT) do { unsigned a0 = pk2(P[BASE + 0], P[BASE + 1]), a1 = pk2(P[BASE + 2], P[BASE + 3]);   \
    unsigned b0 = pk2(P[BASE + 4], P[BASE + 5]), b1 = pk2(P[BASE + 6], P[BASE + 7]);                              \
    auto r0 = __builtin_amdgcn_permlane32_swap(a0, b0, false, false); auto r1 = __builtin_amdgcn_permlane32_swap(a1, b1, false, false); \
    u32x4 w = {r0[0], r1[0], r0[1], r1[1]}; OUT = __builtin_bit_cast(bf16x8, w); } while (0)
    PK4(p0, 0, pa0); PK4(p0, 8, pa1); PK4(p1, 0, pa2); PK4(p1, 8, pa3);
#undef PK4
}
__device__ __forceinline__ float swap_add(float v) {
    auto rr = __builtin_amdgcn_permlane32_swap(__float_as_uint(v), __float_as_uint(v), false, false);
    return __uint_as_float(rr[0]) + __uint_as_float(rr[1]);
}

template <int DQK, int DV, bool QNORM, bool ROPE = false>
__device__ __forceinline__ void dense_unit(const bf16_t* Qb, int ldq, const bf16_t* Kh, const bf16_t* Vh, bf16_t* Ob, int ldo, int seq,
                                           float negm, const float* qg, float qscale, LAS unsigned char* lds, const int wid, float* rsacc = nullptr, const float* tab = nullptr, int pos0 = 0) {
    constexpr int NDQ = DQK / 16, NDV = DV / 32, NVC = DV / 64, KCPR = DQK / 8, VCPR = DV / 8;
    constexpr int SHM_V = 64 * DV * 2, SHM_K = 64 * 256;
    int lane; asm volatile("v_mbcnt_lo_u32_b32 %0, -1, 0\n\tv_mbcnt_hi_u32_b32 %0, -1, %0" : "=v"(lane));
    const int tid = wid * 64 + lane, r32 = lane & 31, hi = lane >> 5;
    LAS unsigned char* V_lds = lds; LAS unsigned char* K_lds = lds + 3 * SHM_V;
    LAS float* wsf = (LAS float*)(lds + 3 * SHM_V + 3 * SHM_K) + wid * 64;
    bf16x8 qr[NDQ];
    {
        const bf16_t* Qw = Qb + (long)(wid * 32 + r32) * ldq + hi * 8;
        if constexpr (!QNORM) {
#pragma unroll
            for (int d0 = 0; d0 < NDQ; ++d0) qr[d0] = *(const bf16x8*)(Qw + d0 * 16);
        } else {
            u32x4 raw[NDQ]; float ss = 0.f;
#pragma unroll
            for (int d0 = 0; d0 < NDQ; ++d0) { raw[d0] = *(const u32x4*)(Qw + d0 * 16); ss += sumsq8(raw[d0]); }
            ss = swap_add(ss);
            const float rs = qscale / sqrtf(ss * (1.0f / DQK) + EPS);
            float x1[8], x2[8];
#pragma unroll
            for (int d0 = 0; d0 < NDQ; ++d0) { float f[8]; unpack8(raw[d0], f); const float* gp = qg + d0 * 16 + hi * 8;
#pragma unroll
                for (int e = 0; e < 8; ++e) f[e] = f[e] * rs * gp[e];
                if (ROPE && d0 == 4) {
#pragma unroll
                    for (int e = 0; e < 8; ++e) x1[e] = f[e];
                } else if (ROPE && d0 == 5) {
#pragma unroll
                    for (int e = 0; e < 8; ++e) x2[e] = f[e];
                } else qr[d0] = __builtin_bit_cast(bf16x8, pack8(f)); }
            if constexpr (ROPE) {
                const int pos = pos0 + wid * 32 + r32; const float* tt = tab + (hi ? (128 + (pos & 63)) : (pos >> 6)) * 16;
                float o1[8], o2[8];
#pragma unroll
                for (int e = 0; e < 8; ++e) { const float cs = tt[e], sn = tt[8 + e]; o1[e] = x1[e] * cs - x2[e] * sn; o2[e] = x2[e] * cs + x1[e] * sn; }
                qr[4] = __builtin_bit_cast(bf16x8, pack8(o1)); qr[5] = __builtin_bit_cast(bf16x8, pack8(o2));
            }
        }
    }
    constexpr bool K2 = true;
    const int kc0 = tid, kc1 = (64 * KCPR == 1024) ? (tid + 512) : (512 + (tid & 255));
    const int vc1 = tid + 512;
    const int kst0 = KSWZ(kc0 / KCPR, (kc0 % KCPR) * 16), kst1 = KSWZ(kc1 / KCPR, (kc1 % KCPR) * 16);
    const int vst0 = v_st<NDV>(kc0 / VCPR, (kc0 % VCPR) * 8), vst1 = v_st<NDV>(vc1 / VCPR, (vc1 % VCPR) * 8);
    const int vb0 = (int)(unsigned)(size_t)V_lds + v_rd_base(lane);
    bf16x8 sEk0, sEk1, sEv0, sEv1, sOk0, sOk1, sOv0, sOv1;
    if constexpr (NVC != 2) { sEv1 = sOv1 = (bf16x8){0, 0, 0, 0, 0, 0, 0, 0}; }
#define SLOAD(S, kk) do { const bf16_t* kp_ = Kh + (long)(kk) * DQK; const bf16_t* vp_ = Vh + (long)(kk) * DV; \
        S##k0 = *(const bf16x8*)(kp_ + kc0 * 8); if (K2) S##k1 = *(const bf16x8*)(kp_ + kc1 * 8); \
        S##v0 = *(const bf16x8*)(vp_ + kc0 * 8); if constexpr (NVC == 2) S##v1 = *(const bf16x8*)(vp_ + vc1 * 8); } while (0)
#define SWRITE(b, S) do { *(LAS bf16x8*)(K_lds + (b) * SHM_K + kst0) = S##k0; if (K2) *(LAS bf16x8*)(K_lds + (b) * SHM_K + kst1) = S##k1; \
        *(LAS bf16x8*)(V_lds + (b) * SHM_V + vst0) = S##v0; if constexpr (NVC == 2) *(LAS bf16x8*)(V_lds + (b) * SHM_V + vst1) = S##v1; } while (0)
#define QKT(P0, P1, b) do { const LAS unsigned char* ks_ = K_lds + (b) * SHM_K; \
        _Pragma("unroll") for (int r = 0; r < 16; ++r) { P0[r] = negm; P1[r] = negm; } \
        _Pragma("unroll") for (int d0 = 0; d0 < NDQ; ++d0) { const int cb = (d0 * 16 + hi * 8) * 2; \
            const bf16x8 b0_ = *(const LAS bf16x8*)(ks_ + KSWZ(r32, cb)); const bf16x8 b1_ = *(const LAS bf16x8*)(ks_ + KSWZ(32 + r32, cb)); \
            P0 = __builtin_amdgcn_mfma_f32_32x32x16_bf16(b0_, qr[d0], P0, 0, 0, 0); P1 = __builtin_amdgcn_mfma_f32_32x32x16_bf16(b1_, qr[d0], P1, 0, 0, 0); } } while (0)
#define PARTIAL(P0) do { _Pragma("unroll") for (int r = 0; r < 16; ++r) P0[r] = __builtin_amdgcn_exp2f(P0[r]); } while (0)
#define FINISH(P0, P1) do { _Pragma("unroll") for (int r = 0; r < 16; ++r) P1[r] = __builtin_amdgcn_exp2f(P1[r]); \
        float ps_ = 0.f; _Pragma("unroll") for (int r = 0; r < 16; ++r) ps_ += P0[r]; _Pragma("unroll") for (int r = 0; r < 16; ++r) ps_ += P1[r]; \
        l_reg += ps_; pack_p(P0, P1, pa0, pa1, pa2, pa3); } while (0)
    float l_reg = 0.f; f32x16 o[NDV];
#pragma unroll
    for (int d = 0; d < NDV; ++d)
#pragma unroll
        for (int r = 0; r < 16; ++r) o[d][r] = 0.f;
    f32x16 pA0, pA1, pB0, pB1; bf16x8 pa0, pa1, pa2, pa3; const int NT = seq / 64;
#define ATT_BAR() asm volatile("s_waitcnt lgkmcnt(0)\n\ts_barrier" ::: "memory")
    SLOAD(sE, 0); SWRITE(0, sE);
    SLOAD(sO, 64); if (2 < NT) SLOAD(sE, 128);
    ATT_BAR();
    SWRITE(1, sO); if (3 < NT) SLOAD(sO, 192);
    QKT(pA0, pA1, 0); PARTIAL(pA0);
    ATT_BAR();
    int s_prev = 0, s_cur = 1, s_next = 2;
    if (wid >= 4) __builtin_amdgcn_s_setprio(1);
#define ROT3() do { s_prev = s_cur; s_cur = s_next; s_next = (s_next == 2) ? 0 : s_next + 1; } while (0)
    for (int j = 1; j + 1 < NT; j += 2) {
        SWRITE(s_next, sE); if (j + 3 < NT) SLOAD(sE, (j + 3) * 64);
        SBAR(); QKT(pB0, pB1, s_cur);
        FINISH(pA0, pA1); SBAR();
        pv_all<NDV>(o, vb0 + s_prev * SHM_V, pa0, pa1, pa2, pa3); PARTIAL(pB0);
        ATT_BAR(); ROT3();
        if (j + 2 < NT) { SWRITE(s_next, sO); if (j + 4 < NT) SLOAD(sO, (j + 4) * 64); }
        SBAR(); QKT(pA0, pA1, s_cur);
        FINISH(pB0, pB1); SBAR();
        pv_all<NDV>(o, vb0 + s_prev * SHM_V, pa0, pa1, pa2, pa3); PARTIAL(pA0);
        ATT_BAR(); ROT3();
    }
    SBAR(); QKT(pB0, pB1, s_cur);
    FINISH(pA0, pA1); SBAR();
    pv_all<NDV>(o, vb0 + s_prev * SHM_V, pa0, pa1, pa2, pa3); PARTIAL(pB0);
    FINISH(pB0, pB1); SBAR();
    pv_all<NDV>(o, vb0 + s_cur * SHM_V, pa0, pa1, pa2, pa3);
#undef ROT3
#undef ATT_BAR
    __builtin_amdgcn_s_setprio(0);
    l_reg = swap_add(l_reg);
    if (hi == 0) wsf[r32] = l_reg; asm volatile("s_waitcnt lgkmcnt(0)" ::: "memory");
    float rli[16];
#pragma unroll
    for (int r = 0; r < 16; ++r) rli[r] = 1.0f / wsf[crow(r, hi)];
    bf16_t* Ow = Ob + (long)(wid * 32) * ldo;
#pragma unroll
    for (int r = 0; r < 16; ++r) { const int orow = crow(r, hi);
#pragma unroll
        for (int d0 = 0; d0 < NDV; ++d0) Ow[(long)orow * ldo + d0 * 32 + r32] = (bf16_t)(pk2(o[d0][r] * rli[r], 0.f) & 0xffffu);
        if (rsacc) { float ss = 0.f;
#pragma unroll
            for (int d0 = 0; d0 < NDV; ++d0) { const float v = o[d0][r] * rli[r]; ss += v * v; }
            ss += xorl<1>(ss); ss += xorl<2>(ss); ss += xorl<4>(ss); ss += xorl<8>(ss); ss += xorl<16>(ss);
            if (r32 == 0) __builtin_amdgcn_global_atomic_fadd_f32((__attribute__((address_space(1))) float*)(rsacc + wid * 32 + orow), ss); } }
    asm volatile("s_waitcnt lgkmcnt(0)\n\ts_barrier" ::: "memory");
#undef SLOAD
#undef SWRITE
#undef QKT
#undef PARTIAL
#undef FINISH
}

__device__ __forceinline__ void na_unit(int b, int r, int h, const bf16_t* Z, bf16_t* OA, float* rsacc, const LAS float* biasT, float negm, LAS unsigned char* wl, LAS float* wsf) {
    const int r0 = min(max(r - 4, 0), 120);
    LAS unsigned char* Kl = wl; LAS unsigned char* Vl = wl + 8192;
#pragma unroll 1
    for (int qb = 0; qb < 2; ++qb) {
        int lane; asm volatile("v_mbcnt_lo_u32_b32 %0, -1, 0\n\tv_mbcnt_hi_u32_b32 %0, -1, %0" : "=v"(lane));
        const int r32 = lane & 31, hi = lane >> 5;
        const int vb = (int)(unsigned)(size_t)Vl + v_rd_base(lane);
        bf16x8 qr[4];
        { const bf16_t* Qp = Z + (long)(b * SEQ + r * 64 + qb * 32 + r32) * ZC + OFF_QNA + h * 64 + hi * 8;
#pragma unroll
          for (int d0 = 0; d0 < 4; ++d0) qr[d0] = *(const bf16x8*)(Qp + d0 * 16); }
        f32x16 o0, o1; float lsum = 0.f;
#pragma unroll
        for (int rr = 0; rr < 16; ++rr) { o0[rr] = 0.f; o1[rr] = 0.f; }
        const int qc = 32 * qb + r32; const int c0 = min(max(qc - 8, 0), 48);
        bf16x8 kst[8], vst[8];
        const bf16_t* srcb0 = Z + ((long)b * SEQ + (long)r0 * 64 + (lane >> 3)) * ZC + h * 64 + (lane & 7) * 8;
#pragma unroll
        for (int i = 0; i < 8; ++i) { kst[i] = *(const bf16x8*)(srcb0 + (long)(8 * i) * ZC + OFF_KNA); vst[i] = *(const bf16x8*)(srcb0 + (long)(8 * i) * ZC + OFF_VNA); }
#pragma unroll 1
        for (int j = 0; j < 8; ++j) {
#pragma unroll
            for (int i = 0; i < 8; ++i) { const int row = (lane >> 3) + 8 * i, cc = lane & 7; *(LAS bf16x8*)(Kl + row * 128 + ((cc * 16) ^ ((row & 7) << 4))) = kst[i]; }
#pragma unroll
            for (int i = 0; i < 8; ++i) { const int row = (lane >> 3) + 8 * i, cc = lane & 7; *(LAS bf16x8*)(Vl + v_st<2>(row, cc * 8)) = vst[i]; }
            asm volatile("" ::: "memory");
            if (j + 1 < 8) { const bf16_t* srcb = srcb0 + (long)(j + 1) * 64 * ZC;
#pragma unroll
                for (int i = 0; i < 8; ++i) { kst[i] = *(const bf16x8*)(srcb + (long)(8 * i) * ZC + OFF_KNA); vst[i] = *(const bf16x8*)(srcb + (long)(8 * i) * ZC + OFF_VNA); } }
            asm volatile("" ::: "memory");
            int brel = 4 * hi - c0, bdc = 4 * hi - qc + 15; asm volatile("" : "+v"(brel), "+v"(bdc));
            const LAS float* brow = biasT + (r0 + j - r + 7) * 32;
            f32x16 p0, p1;
#pragma unroll
            for (int rr = 0; rr < 16; ++rr) { p0[rr] = negm; p1[rr] = negm; }
#pragma unroll
            for (int d0 = 0; d0 < 4; ++d0) { const int cb = ((d0 * 32 + hi * 16) ^ ((r32 & 7) << 4));
                const bf16x8 k0 = *(const LAS bf16x8*)(Kl + r32 * 128 + cb); const bf16x8 k1 = *(const LAS bf16x8*)(Kl + (32 + r32) * 128 + cb);
                p0 = __builtin_amdgcn_mfma_f32_32x32x16_bf16(k0, qr[d0], p0, 0, 0, 0); p1 = __builtin_amdgcn_mfma_f32_32x32x16_bf16(k1, qr[d0], p1, 0, 0, 0); }
            float ps = 0.f;
#define NA_ELEM(P, RR, KOFF) do { const int kk_ = ((RR) & 3) + 8 * ((RR) >> 2) + (KOFF); const int rel_ = brel + kk_; const bool valid_ = (unsigned)rel_ < 16u; const int dc_ = valid_ ? (bdc + kk_) : 0; \
                const float e_ = __builtin_amdgcn_exp2f(P[RR] + brow[dc_]); P[RR] = valid_ ? e_ : 0.f; ps += P[RR]; } while (0)
            if (qb == 0) {
#pragma unroll
                for (int rr = 0; rr < 16; ++rr) NA_ELEM(p0, rr, 0);
#pragma unroll
                for (int rr = 0; rr < 4; ++rr) NA_ELEM(p1, rr, 32);
#pragma unroll
                for (int rr = 4; rr < 16; ++rr) p1[rr] = 0.f;
            } else {
#pragma unroll
                for (int rr = 12; rr < 16; ++rr) NA_ELEM(p0, rr, 0);
#pragma unroll
                for (int rr = 0; rr < 12; ++rr) p0[rr] = 0.f;
#pragma unroll
                for (int rr = 0; rr < 16; ++rr) NA_ELEM(p1, rr, 32);
            }
#undef NA_ELEM
            lsum += ps;
            bf16x8 pa0, pa1, pa2, pa3; pack_p(p0, p1, pa0, pa1, pa2, pa3);
            pv_one<2, 0>(o0, vb, pa0, pa1, pa2, pa3); pv_one<2, 1>(o1, vb, pa0, pa1, pa2, pa3);
            asm volatile("s_waitcnt lgkmcnt(0)" ::: "memory");
        }
        lsum = swap_add(lsum);
        if (hi == 0) wsf[r32] = lsum;
        asm volatile("s_waitcnt lgkmcnt(0)" ::: "memory");
#pragma unroll
        for (int rr = 0; rr < 16; ++rr) { const int orow = crow(rr, hi); const float rl = 1.0f / wsf[orow];
            const long trow = (long)(b * SEQ + r * 64 + qb * 32 + orow);
            bf16_t* op = OA + trow * 1024 + h * 64 + r32;
            const float v0 = o0[rr] * rl, v1 = o1[rr] * rl;
            op[0] = (bf16_t)(pk2(v0, 0.f) & 0xffffu); op[32] = (bf16_t)(pk2(v1, 0.f) & 0xffffu);
            float ss = v0 * v0 + v1 * v1;
            ss += xorl<1>(ss); ss += xorl<2>(ss); ss += xorl<4>(ss); ss += xorl<8>(ss); ss += xorl<16>(ss);
            if (r32 == 0) __builtin_amdgcn_global_atomic_fadd_f32((__attribute__((address_space(1))) float*)(rsacc + trow), ss); }
        asm volatile("s_waitcnt lgkmcnt(0)" ::: "memory");
    }
}
#undef KSWZ
#undef SBAR
}


#define XB_TMO      128
#define XB_XCNT(j)  (256  + 64 * (j))
#define XB_XSUB(j)  (1280 + 64 * (j))
#define XB_XGEN(j)  (2304 + 64 * (j))
#define XB_TOP      3328
#define XB_TOPGEN   3392
#define XCD_BAR_WORDS 3456
#define XB_SPIN_CAP (1u << 18)
__device__ __forceinline__ unsigned xb_ld(unsigned* p)              { return __hip_atomic_load(p, __ATOMIC_RELAXED, __HIP_MEMORY_SCOPE_AGENT); }
__device__ __forceinline__ unsigned xb_add(unsigned* p, unsigned v) { return __hip_atomic_fetch_add(p, v, __ATOMIC_RELAXED, __HIP_MEMORY_SCOPE_AGENT); }
__device__ __forceinline__ unsigned xb_xcc_id() { return (unsigned)__builtin_amdgcn_s_getreg((3 << 11) | 20) & 0xFu; }
#define XB_SPIN(cond, bar) do { unsigned _sp = 0; while (cond) { __builtin_amdgcn_s_sleep(1); \
    if ((++_sp & 255u) == 0u) { if (xb_ld(&(bar)[XB_TMO])) break; if (_sp > XB_SPIN_CAP) { atomicAdd(&(bar)[XB_TMO], 1u); break; } } } } while (0)
struct XcdBarrier { unsigned* bar; unsigned x; volatile LAS unsigned* st; };
__device__ __forceinline__ void xcd_barrier_complete(unsigned* bar, unsigned x, unsigned& nloc, unsigned& nx) {
    const unsigned G = gridDim.x * gridDim.y * gridDim.z;
    unsigned sum, cnt, mine, sp = 0u;
    for (;;) {
        sum = 0u; cnt = 0u; mine = 0u;
#pragma unroll 1
        for (unsigned j = 0; j < 16; ++j) { const unsigned c = xb_ld(&bar[XB_XCNT(j)]); sum += c; cnt += (c > 0u) ? 1u : 0u; mine = (j == x) ? c : mine; }
        if (sum == G) break;
        __builtin_amdgcn_s_sleep(1);
        if ((++sp & 255u) == 0u) { if (xb_ld(&bar[XB_TMO])) break; if (sp > XB_SPIN_CAP) { atomicAdd(&bar[XB_TMO], 1u); break; } }
    }
    nloc = mine > 0u ? mine : 1u; nx = cnt > 0u ? cnt : 1u;
}
__device__ __forceinline__ void xcd_barrier(unsigned* bar, unsigned x, volatile LAS unsigned* st, bool is_t0) {
    asm volatile("s_waitcnt vmcnt(0)" ::: "memory");
    __syncthreads();
    if (is_t0) {
        __builtin_amdgcn_s_waitcnt(0);
        unsigned nloc = st[0], nx = st[1];
        if (nloc == 0u) { xcd_barrier_complete(bar, x, nloc, nx); st[0] = nloc; st[1] = nx; }
        const unsigned old = xb_add(&bar[XB_XSUB(x)], 1u);
        const unsigned gen = old / nloc;
        if (old + 1u == (gen + 1u) * nloc) {
            __builtin_amdgcn_fence(__ATOMIC_RELEASE, "agent");
            asm volatile("s_waitcnt vmcnt(0)" ::: "memory");
            const unsigned og = xb_add(&bar[XB_TOP], 1u);
            const unsigned tg = og / nx;
            if (og + 1u == (tg + 1u) * nx) xb_add(&bar[XB_TOPGEN], 1u);
            else XB_SPIN(xb_ld(&bar[XB_TOPGEN]) == tg, bar);
            __builtin_amdgcn_fence(__ATOMIC_ACQUIRE, "agent");
            xb_add(&bar[XB_XGEN(x)], 1u);
            asm volatile("s_waitcnt vmcnt(0)" ::: "memory");
        } else {
            XB_SPIN(xb_ld(&bar[XB_XGEN(x)]) == gen, bar);
            __builtin_amdgcn_fence(__ATOMIC_ACQUIRE, "agent");
            asm volatile("s_waitcnt vmcnt(0)" ::: "memory");
        }
    }
    __syncthreads();
}

struct Args { const float* in[27]; float* out; unsigned char* ws; int ph_lo, ph_hi; unsigned prog[24]; };
__device__ __forceinline__ int opaque_idx(int i) { asm volatile("" : "+s"(i)); return i; }
__device__ __forceinline__ unsigned opaque_zero() { unsigned z = 0u; asm volatile("" : "+v"(z)); return z; }
enum { I_X = 0, I_MEM, I_MIXG, I_WIN, I_NAQG, I_NAKG, I_RPB, I_QLATG, I_KVLATG, I_WUQ, I_WUKV, I_MLAQG, I_MLAKG, I_GRPG, I_WOUT, I_MEMNG, I_MEMTOKG,
       I_MWQ, I_MWKV, I_MQG, I_MKG, I_MWO, I_FFNG, I_WUP, I_CONVW, I_CONVB, I_WDN };

__device__ __forceinline__ void xpose_item(const float* W, int K, int N, bf16_t* WT, LAS float* scr, int item, int lane, const float* gk = nullptr, int rowmap = 0) {
    const int nblk = N / 32, kb = item / nblk, nb = item % nblk, k0 = 64 * kb, n0 = 32 * nb;
#pragma unroll
    for (int i = 0; i < 32; ++i) { const int kk = 2 * i + (lane >> 5); float w = W[(size_t)(k0 + kk) * N + n0 + (lane & 31)]; if (gk) w *= gk[k0 + kk]; scr[kk * 33 + (lane & 31)] = w; }
    asm volatile("s_waitcnt lgkmcnt(0)" ::: "memory");
    const int c = lane & 7;
    const int r0 = (rowmap == 0) ? n0 : ((n0 < DFF) ? ((n0 >> 7) * 256 + (n0 & 127)) : (((n0 - DFF) >> 7) * 256 + 128 + ((n0 - DFF) & 127)));
#pragma unroll
    for (int j = 0; j < 4; ++j) { const int n = (lane >> 3) + 8 * j; const LAS float* s = scr + (8 * c) * 33 + n;
        u32x4 o; o.x = pk2(s[0 * 33], s[1 * 33]); o.y = pk2(s[2 * 33], s[3 * 33]); o.z = pk2(s[4 * 33], s[5 * 33]); o.w = pk2(s[6 * 33], s[7 * 33]);
        *(u32x4*)(WT + (size_t)(r0 + n) * K + k0 + 8 * c) = o; }
    asm volatile("s_waitcnt lgkmcnt(0)" ::: "memory");
}

__device__ __forceinline__ void norm_row(const float* xrow, const float* g, bf16_t* orow, int lane) {
    const f32x4* xr = (const f32x4*)xrow + lane; const f32x4* gr = (const f32x4*)g + lane;
    f32x4 v[4]; float ss = 0.f;
#pragma unroll
    for (int j = 0; j < 4; ++j) { v[j] = xr[64 * j]; ss += (v[j].x * v[j].x + v[j].y * v[j].y) + (v[j].z * v[j].z + v[j].w * v[j].w); }
    ss = wave_sum(ss);
    const float rstd = 1.0f / sqrtf(ss * (1.0f / 1024.0f) + EPS);
    u32x2* o = (u32x2*)orow + lane;
#pragma unroll
    for (int j = 0; j < 4; ++j) { const f32x4 gg = gr[64 * j]; u32x2 w; w.x = pk2(v[j].x * rstd * gg.x, v[j].y * rstd * gg.y); w.y = pk2(v[j].z * rstd * gg.z, v[j].w * rstd * gg.w); o[64 * j] = w; }
}

__device__ __forceinline__ void sincos_f(float a, float& s, float& c) {
    const float k = rintf(a * 0.636619772367581343f);
    float r = fmaf(-k, 1.57079637050628662109375f, a); r = fmaf(-k, -4.37113900018624283e-8f, r);
    const float r2 = r * r;
    const float sp = r * (1.0f + r2 * (-1.0f / 6 + r2 * (1.0f / 120 + r2 * (-1.0f / 5040 + r2 * (1.0f / 362880 + r2 * (-1.0f / 39916800))))));
    const float cp = 1.0f + r2 * (-0.5f + r2 * (1.0f / 24 + r2 * (-1.0f / 720 + r2 * (1.0f / 40320 + r2 * (-1.0f / 3628800 + r2 * (1.0f / 479001600))))));
    const int q = ((int)k) & 3;
    s = (q == 0) ? sp : (q == 1) ? cp : (q == 2) ? -sp : -cp;
    c = (q == 0) ? cp : (q == 1) ? -sp : (q == 2) ? -cp : sp;
}

#ifndef LBT
#define LBT 512
#endif
__global__ void __launch_bounds__(LBT, 2) mega_fwd(Args args) {
    extern __shared__ __attribute__((aligned(16))) unsigned char lds_raw[];
    LAS unsigned char* lds = (LAS unsigned char*)lds_raw;
    const int G = gridDim.x, bx = blockIdx.x;
    const int wave = __builtin_amdgcn_readfirstlane((int)threadIdx.x >> 6);
    volatile LAS unsigned* bst = (volatile LAS unsigned*)(lds + LDS_MISC);
    if (threadIdx.x == 0) { bst[0] = 0u; bst[1] = 0u; }
    __syncthreads();
    const unsigned xcc = xb_xcc_id();
    float* out = args.out;
    const float* x_in = args.in[opaque_idx(I_X)];
#define TAB ((float*)(ws + WS_TAB))
#define XN ((bf16_t*)(ws + WS_XN))
#define Zb ((bf16_t*)(ws + WS_Z))
#define QM ((bf16_t*)(ws + WS_QM))
#define KVM ((bf16_t*)(ws + WS_KVM))
#define QA ((bf16_t*)(ws + WS_QA))
#define KA ((bf16_t*)(ws + WS_KA))
#define VA ((bf16_t*)(ws + WS_VA))
#define OA ((bf16_t*)(ws + WS_OA))
#define OB ((bf16_t*)(ws + WS_OB))
#define MIX ((bf16_t*)(ws + WS_MIX))
#define QC ((bf16_t*)(ws + WS_QC))
#define OC ((bf16_t*)(ws + WS_OC))
#define Ub ((bf16_t*)(ws + WS_U))
#define ACT ((bf16_t*)(ws + WS_ACT))

    for (int ph = args.ph_lo; ph < args.ph_hi; ++ph) {
        __attribute__((address_space(1))) unsigned char* wsg = (__attribute__((address_space(1))) unsigned char*)args.ws; asm volatile("" : "+s"(wsg));
        unsigned char* ws = (unsigned char*)wsg;
        int lane; asm volatile("v_mbcnt_lo_u32_b32 %0, -1, 0\n\tv_mbcnt_hi_u32_b32 %0, -1, %0" : "=v"(lane));
        const int gw = bx * 8 + wave, NGW = G * 8;
#define TIDX (wave * 64 + lane)
        const int pcode = (int)((args.prog[opaque_idx(ph >> 2)] >> ((ph & 3) * 8)) & 255u);
        if (pcode == 255) {
            LAS float* scr = (LAS float*)(lds + wave * 16384);
            constexpr int IT_IN = 16 * 69, IT_UQ = 6 * 24, IT_UKV = 4 * 32, IT_OUT = 16 * 32, IT_MQ = 16 * 16, IT_MKV = 16 * 32, IT_MO = 8 * 32, IT_UP = 16 * 176, IT_DN = 44 * 32;
            constexpr int IT_L = IT_IN + IT_UQ + IT_UKV + IT_OUT + IT_MQ + IT_MKV + IT_MO + IT_UP + IT_DN;
            for (int it = gw; it < 2 * IT_L; it += NGW) {
                const int l = it / IT_L; int r = it - l * IT_L;
                unsigned char* wb = ws + WS_W + (size_t)l * W_LAYER;
                if (r < IT_IN) { xpose_item(args.in[opaque_idx(I_WIN)] + (size_t)l * 1024 * IN_COLS, 1024, IN_COLS, (bf16_t*)(wb + W_IN), scr, r, lane, args.in[opaque_idx(I_MIXG)] + l * DM); continue; } r -= IT_IN;
                if (r < IT_UQ) { xpose_item(args.in[opaque_idx(I_WUQ)] + (size_t)l * 384 * 768, 384, 768, (bf16_t*)(wb + W_UQ), scr, r, lane); continue; } r -= IT_UQ;
                if (r < IT_UKV) { xpose_item(args.in[opaque_idx(I_WUKV)] + (size_t)l * 256 * 1024, 256, 1024, (bf16_t*)(wb + W_UKV), scr, r, lane); continue; } r -= IT_UKV;
                if (r < IT_OUT) { xpose_item(args.in[opaque_idx(I_WOUT)] + (size_t)l * 1024 * 1024, 1024, 1024, (bf16_t*)(wb + W_OUT), scr, r, lane, args.in[opaque_idx(I_GRPG)] + l * 1024); continue; } r -= IT_OUT;
                if (r < IT_MQ) { xpose_item(args.in[opaque_idx(I_MWQ)] + (size_t)l * 1024 * 512, 1024, 512, (bf16_t*)(wb + W_MQ), scr, r, lane, args.in[opaque_idx(I_MEMNG)] + l * DM); continue; } r -= IT_MQ;
                if (r < IT_MKV) { xpose_item(args.in[opaque_idx(I_MWKV)] + (size_t)l * 1024 * 1024, 1024, 1024, (bf16_t*)(wb + W_MKV), scr, r, lane); continue; } r -= IT_MKV;
                if (r < IT_MO) { xpose_item(args.in[opaque_idx(I_MWO)] + (size_t)l * 512 * 1024, 512, 1024, (bf16_t*)(wb + W_MO), scr, r, lane); continue; } r -= IT_MO;
                if (r < IT_UP) { xpose_item(args.in[opaque_idx(I_WUP)] + (size_t)l * 1024 * DFF2, 1024, DFF2, (bf16_t*)(wb + W_UP), scr, r, lane, args.in[opaque_idx(I_FFNG)] + l * DM, 1); continue; } r -= IT_UP;
                xpose_item(args.in[opaque_idx(I_WDN)] + (size_t)l * DFF * 1024, DFF, 1024, (bf16_t*)(wb + W_DN), scr, r, lane);
            }
            for (int i = bx * 512 + TIDX; i < 2 * 96 * 1024 / 8; i += G * 512) { const int l = i / (96 * 128), rr = i % (96 * 128);
                const unsigned z = opaque_zero();
                *(u32x4*)(ws + WS_W + (size_t)l * W_LAYER + W_IN + (size_t)IN_COLS * 1024 * 2 + (size_t)rr * 16) = (u32x4){z, z, z, z}; }
            if (bx == 0) { for (int i = TIDX; i < (int)(BAR_BYTES / 4); i += 512) ((unsigned*)(ws + WS_BAR))[i] = opaque_zero(); }
            for (int e = bx * 512 + TIDX; e < 192 * 8; e += G * 512) { const int p = e >> 3, j = e & 7; const int pos = p < 128 ? p : p - 128;
                const float inv = ((j & 1) ? 0.31622776601683794f : 1.0f) * ((j >> 1) == 0 ? 1.0f : (j >> 1) == 1 ? 0.1f : (j >> 1) == 2 ? 0.01f : 0.001f);
                float s, c; sincos_f((float)pos * inv, s, c); TAB[p * 16 + j] = c; TAB[p * 16 + 8 + j] = s; }
            {
                f32x4 nx[4];
                { const f32x4* xr = (const f32x4*)(x_in + (size_t)gw * DM) + lane;
#pragma unroll
                  for (int j = 0; j < 4; ++j) nx[j] = xr[64 * j]; }
                for (int m = gw; m < T; m += NGW) {
                    f32x4 v[4];
#pragma unroll
                    for (int j = 0; j < 4; ++j) v[j] = nx[j];
                    if (m + NGW < T) { const f32x4* xr = (const f32x4*)(x_in + (size_t)(m + NGW) * DM) + lane;
#pragma unroll
                        for (int j = 0; j < 4; ++j) nx[j] = xr[64 * j]; }
                    u32x2* o = (u32x2*)(XN + (size_t)m * DM) + lane; float ss = 0.f;
#pragma unroll
                    for (int j = 0; j < 4; ++j) { ss += (v[j].x * v[j].x + v[j].y * v[j].y) + (v[j].z * v[j].z + v[j].w * v[j].w); u32x2 w; w.x = pk2(v[j].x, v[j].y); w.y = pk2(v[j].z, v[j].w); o[64 * j] = w; }
                    ss = wave_sum(ss); if (lane == 0) ((float*)(ws + WS_RS))[m] = ss;
                }
            }
            for (int i = bx * 512 + TIDX; i < 9 * T / 4; i += G * 512) { const unsigned z = opaque_zero(); ((u32x4*)(ws + WS_RS) + T / 4)[i] = (u32x4){z, z, z, z}; }
            for (int m = gw; m < 2 * MEMT; m += NGW) { const int l = m / MEMT, rr = m % MEMT;
                norm_row(args.in[opaque_idx(I_MEM)] + (size_t)rr * DM, args.in[opaque_idx(I_MEMTOKG)] + l * DM, (bf16_t*)(ws + WS_MEMN) + (size_t)m * DM, lane); }
        } else {
            const int l = pcode >> 5, s = pcode & 31;
            unsigned char* wb = ws + WS_W + (size_t)l * W_LAYER;
            const int kind = (s == 1 || s == 3 || s == 7 || s == 9 || s == 11 || s == 13 || s == 15 || s == 17) ? 1 : 0;
            if (kind == 1 && EN_GEMM) {
                const int ng = (s == 1 || s == 3) ? 2 : 1;
#pragma unroll 1
                for (int gi = 0; gi < ng; ++gi) {
                    pg8::Gemm g{nullptr, nullptr, 0, 0, 0, 0, nullptr, nullptr, 256, 0}; pg8::EpiDesc e{0, 0, nullptr, nullptr, nullptr, nullptr, nullptr};
                    float* const RSB = (float*)(ws + WS_RS);
                    switch (s * 2 + gi) {
                    case 2: g = pg8::Gemm{XN, (const bf16_t*)(wb + W_IN), T, ZC, 1024, 1024, nullptr, nullptr, 256, 0}; e = pg8::EpiDesc{0, ZC, Zb, nullptr, RSB + (size_t)(l * 3 + 0) * T, nullptr, nullptr}; break;
                    case 3: g = pg8::Gemm{(const bf16_t*)(ws + WS_MEMN) + (size_t)l * MEMT * DM, (const bf16_t*)(wb + W_MKV), MEMT, 1024, 1024, 1024, nullptr, nullptr, 256, 0};
                            e = pg8::EpiDesc{0, 1024, (bf16_t*)(ws + WS_KVCR) + (size_t)l * MEMT * 1024, nullptr, nullptr, nullptr, nullptr}; break;
                    case 6: g = pg8::Gemm{Zb + OFF_CQ, (const bf16_t*)(wb + W_UQ), T, 768, 384, ZC, nullptr, nullptr, 256, 0}; e = pg8::EpiDesc{0, 768, QM, nullptr, nullptr, nullptr, nullptr}; break;
                    case 7: g = pg8::Gemm{Zb + OFF_CKV, (const bf16_t*)(wb + W_UKV), T, 1024, 256, ZC, nullptr, nullptr, 256, 0}; e = pg8::EpiDesc{0, 1024, KVM, nullptr, nullptr, nullptr, nullptr}; break;
                    case 14: g = pg8::Gemm{MIX, (const bf16_t*)(wb + W_OUT), T, 1024, 1024, 1024, RSB + (size_t)(6 + 2 * l) * T, RSB + (size_t)(7 + 2 * l) * T, 256, 0}; e = pg8::EpiDesc{1, 1024, out, (l == 0) ? x_in : (const float*)out, RSB + (size_t)(l * 3 + 1) * T, XN, RSB + (size_t)(7 + 2 * l) * T}; break;
                    case 18: g = pg8::Gemm{XN, (const bf16_t*)(wb + W_MQ), T, 512, 1024, 1024, nullptr, nullptr, 256, 0}; e = pg8::EpiDesc{0, 512, QC, nullptr, RSB + (size_t)(l * 3 + 1) * T, nullptr, nullptr}; break;
                    case 22: g = pg8::Gemm{OC, (const bf16_t*)(wb + W_MO), T, 1024, 512, 512, nullptr, nullptr, 256, 0}; e = pg8::EpiDesc{1, 1024, out, out, RSB + (size_t)(l * 3 + 2) * T, XN, nullptr}; break;
                    case 26: g = pg8::Gemm{XN - DM, (const bf16_t*)(wb + W_UP), 130 * 256, DFF2, 1024, 1024, nullptr, nullptr, 254, 0};
                             e = pg8::EpiDesc{2, DFF, ACT, args.in[opaque_idx(I_CONVW)] + (size_t)l * 3 * DFF2, RSB + (size_t)(l * 3 + 2) * T, nullptr, args.in[opaque_idx(I_CONVB)] + (size_t)l * DFF2}; break;
                    case 34: g = pg8::Gemm{ACT, (const bf16_t*)(wb + W_DN), T, 1024, DFF, DFF, nullptr, nullptr, 256, 0}; e = pg8::EpiDesc{1, 1024, out, out, RSB + (size_t)(l * 3 + 3) * T, (l == 0) ? XN : nullptr, nullptr}; break;
                    default: break;
                    }
                    LAS pg8::EpiDesc* dl = (LAS pg8::EpiDesc*)(lds + 131072 + 256);
                    __syncthreads();
                    LAS pg8::Gemm* gl = (LAS pg8::Gemm*)(lds + 131072 + 512);
                    if (wave == 0 && lane == 0) { gl->A = g.A; gl->Bt = g.Bt; gl->M = g.M; gl->N = g.N; gl->K = g.K; gl->lda = g.lda; gl->mida = g.mida; gl->midb = g.midb; gl->trows = g.trows; }
                    if (wave == 0 && lane == 0) { dl->mode = e.mode; dl->ldc = e.ldc; dl->dst = e.dst; dl->base = e.base; dl->rs = e.rs; dl->xb = e.xb; dl->rs2 = e.rs2; }
                    __syncthreads();
                    pg8::StaticOrder S; S.init(g.M, g.N, G, (s == 1 && gi == 1) ? ((bx + (G >> 1)) % G) : bx);
                    if (s == 13) { pg8::EpiConv E{dl}; pg8::gemm_phase<pg8::EpiConv, pg8::StaticOrder>(lds, gl, S, E, wave); }
                    else { pg8::EpiUni E{dl}; pg8::gemm_phase<pg8::EpiUni, pg8::StaticOrder>(lds, gl, S, E, wave); }
                }
            } else if (s == 2 && EN_P1) {
                const float* gq = args.in[opaque_idx(I_NAQG)] + l * 64; const float* gk = args.in[opaque_idx(I_NAKG)] + l * 64;
                const float* gcq = args.in[opaque_idx(I_QLATG)] + l * 384; const float* gckv = args.in[opaque_idx(I_KVLATG)] + l * 256;
                const unsigned z0 = opaque_zero();
                u32x4 nq, nk, n4, n5 = (u32x4){z0, z0, z0, z0};
                { const u32x4* zn = (const u32x4*)(Zb + (size_t)gw * ZC); nq = zn[lane]; nk = zn[64 + lane]; n4 = zn[192 + lane]; if (lane < 16) n5 = zn[256 + lane]; }
                for (int row = gw; row < T; row += NGW) {
                    u32x4* z = (u32x4*)(Zb + (size_t)row * ZC);
                    const u32x4 vq = nq, vk = nk, v4 = n4, v5 = n5;
                    if (row + NGW < T) { const u32x4* zn = (const u32x4*)(Zb + (size_t)(row + NGW) * ZC); nq = zn[lane]; nk = zn[64 + lane]; n4 = zn[192 + lane]; if (lane < 16) n5 = zn[256 + lane]; }
                    float fq[8], fk[8], f4[8], f5[8]; unpack8(vq, fq); unpack8(vk, fk); unpack8(v4, f4); unpack8(v5, f5);
                    float sq = 0.f, sk = 0.f, s4 = 0.f, s5 = 0.f;
#pragma unroll
                    for (int e = 0; e < 8; ++e) { sq += fq[e] * fq[e]; sk += fk[e] * fk[e]; s4 += f4[e] * f4[e]; s5 += f5[e] * f5[e]; }
                    sq += xorl<1>(sq); sq += xorl<2>(sq); sq += xorl<4>(sq);
                    sk += xorl<1>(sk); sk += xorl<2>(sk); sk += xorl<4>(sk);
                    const float scq = wave_sum(lane < 48 ? s4 : 0.f);
                    const float sckv = wave_sum((lane >= 48 ? s4 : 0.f) + (lane < 16 ? s5 : 0.f));
                    const float rq = (0.125f * LOG2E) / sqrtf(sq * (1.0f / 64.0f) + EPS), rk = 1.0f / sqrtf(sk * (1.0f / 64.0f) + EPS);
                    const float rcq = 1.0f / sqrtf(scq * (1.0f / 384.0f) + EPS), rckv = 1.0f / sqrtf(sckv * (1.0f / 256.0f) + EPS);
                    const int hc = (lane & 7) * 8;
                    const float* g4 = (lane < 48) ? (gcq + lane * 8) : (gckv + (lane - 48) * 8); const float r4 = (lane < 48) ? rcq : rckv;
                    const float* g5 = gckv + (16 + (lane & 15)) * 8;
#pragma unroll
                    for (int e = 0; e < 8; ++e) { fq[e] *= rq * gq[hc + e]; fk[e] *= rk * gk[hc + e]; f4[e] *= r4 * g4[e]; f5[e] *= rckv * g5[e]; }
                    z[lane] = pack8(fq); z[64 + lane] = pack8(fk); z[192 + lane] = pack8(f4); if (lane < 16) z[256 + lane] = pack8(f5);
                }
                const float* gmk = args.in[opaque_idx(I_MKG)] + l * 128;
                for (int row = gw; row < MEMT; row += NGW) {
                    const u32x4* src = (const u32x4*)((bf16_t*)(ws + WS_KVCR) + ((size_t)l * MEMT + row) * 1024);
                    const u32x4 vk = src[lane], vv = src[64 + lane];
                    float fk[8]; unpack8(vk, fk); float sk = 0.f;
#pragma unroll
                    for (int e = 0; e < 8; ++e) sk += fk[e] * fk[e];
                    sk += xorl<1>(sk); sk += xorl<2>(sk); sk += xorl<4>(sk); sk += xorl<8>(sk);
                    const float rk = 1.0f / sqrtf(sk * (1.0f / 128.0f) + EPS);
                    const int hc = (lane & 15) * 8, hd = lane >> 4, b = row >> 8, m = row & 255;
#pragma unroll
                    for (int e = 0; e < 8; ++e) fk[e] *= rk * gmk[hc + e];
                    const size_t dst = ((size_t)l * MEMT * 512) + (((size_t)(b * 4 + hd) * 256 + m) * 128 + hc);
                    *(u32x4*)((bf16_t*)(ws + WS_KC) + dst) = pack8(fk);
                    *(u32x4*)((bf16_t*)(ws + WS_VC) + dst) = vv;
                }
            } else if (s == 4 && EN_P2) {
                const float* gq = args.in[opaque_idx(I_MLAQG)] + l * 96; const float* gk = args.in[opaque_idx(I_MLAKG)] + l * 96;
                const float qsc = 0.10206207261596575f * LOG2E;
                for (int rep = 0; rep < REP_EW; ++rep)
                for (int idx = bx * 512 + TIDX; idx < T * 8; idx += G * 512) {
                    const int tok = idx >> 3, h = idx & 7, b = tok >> 13, sp = tok & 8191, prow = sp >> 6, pcol = sp & 63;
                    const float* tr = TAB + prow * 16; const float* tc = TAB + (128 + pcol) * 16;
                    const size_t dq = ((size_t)(b * 8 + h) * SEQ + sp) * 96;
                    {
                        const u32x4* srck = (const u32x4*)(KVM + (size_t)tok * 1024 + h * 128);
                        const u32x4* srcr = (const u32x4*)(Zb + (size_t)tok * ZC + OFF_KR);
                        u32x4 c[12]; float ss = 0.f;
#pragma unroll
                        for (int i = 0; i < 8; ++i) { c[i] = srck[i]; ss += sumsq8(c[i]); }
#pragma unroll
                        for (int i = 0; i < 4; ++i) { c[8 + i] = srcr[i]; ss += sumsq8(c[8 + i]); }
                        const float rs = 1.0f / sqrtf(ss * (1.0f / 96.0f) + EPS);
                        u32x4* dst = (u32x4*)(KA + dq);
#pragma unroll
                        for (int i = 0; i < 8; ++i) { float f[8]; unpack8(c[i], f);
#pragma unroll
                            for (int e = 0; e < 8; ++e) f[e] *= rs * gk[i * 8 + e];
                            dst[i] = pack8(f); }
#pragma unroll
                        for (int i = 0; i < 2; ++i) { float x1[8], x2[8], o1[8], o2[8]; unpack8(c[8 + i], x1); unpack8(c[10 + i], x2); const float* tt = i ? tc : tr;
#pragma unroll
                            for (int e = 0; e < 8; ++e) { const float a = x1[e] * rs * gk[64 + i * 8 + e], bb = x2[e] * rs * gk[80 + i * 8 + e]; const float cs = tt[e], sn = tt[8 + e];
                                o1[e] = a * cs - bb * sn; o2[e] = bb * cs + a * sn; }
                            dst[8 + i] = pack8(o1); dst[10 + i] = pack8(o2); }
                        u32x4* dv = (u32x4*)(VA + ((size_t)(b * 8 + h) * SEQ + sp) * 64);
#pragma unroll
                        for (int i = 0; i < 8; ++i) dv[i] = srck[8 + i];
                    }
                }
            } else if (s == 5 && EN_ATT) {
                if (EN_MLA) {
                    const float* gq = args.in[opaque_idx(I_MLAQG)] + l * 96; const float* gk = args.in[opaque_idx(I_MLAKG)] + l * 96;
                    float mq = fmaxf(fabsf(gq[lane]), lane < 32 ? fabsf(gq[64 + lane]) : 0.f), mk = fmaxf(fabsf(gk[lane]), lane < 32 ? fabsf(gk[64 + lane]) : 0.f);
                    mq = wave_max(mq); mk = wave_max(mk);
                    const float negm = -(9.797958971132712f * mq * mk * LOG2E);
                    for (int rep = 0; rep < REP_MLA; ++rep)
                    for (int i = 0;; ++i) {
                        int bh, qb;
                        if (G == 256) { if (i >= 4) break; bh = i * 8 + (bx & 7); qb = bx >> 3; }
                        else { const int u = bx + i * G; if (u >= 1024) break; bh = u >> 5; qb = u & 31; }
                        const int b = bh >> 3, h = bh & 7;
                        att::dense_unit<96, 64, true, true>(QM + ((size_t)b * SEQ + qb * 256) * 768 + h * 96, 768, KA + (size_t)bh * SEQ * 96, VA + (size_t)bh * SEQ * 64,
                                                       MIX + ((size_t)b * SEQ + qb * 256) * 1024 + 512 + h * 64, 1024, SEQ, negm, gq, 0.10206207261596575f * LOG2E, lds, wave, (float*)(ws + WS_RS) + (size_t)(7 + 2 * l) * T + (size_t)b * SEQ + qb * 256, TAB, qb * 256);
                    }
                }
                if (EN_NA) {
                    int lane; asm volatile("v_mbcnt_lo_u32_b32 %0, -1, 0\n\tv_mbcnt_hi_u32_b32 %0, -1, %0" : "=v"(lane));
                    const int h = wave;
                    LAS unsigned char* wl = lds + wave * 16384; LAS float* biasT = (LAS float*)(lds + 131072 + wave * 2048); LAS float* wsf = (LAS float*)(lds + 131072 + 16384 + wave * 256);
                    const float* rp = args.in[opaque_idx(I_RPB)] + ((size_t)l * 8 + h) * 15 * 31;
                    float bm = 0.f;
                    for (int i = lane; i < 15 * 32; i += 64) { const int dr = i >> 5, dc = i & 31; const float v = (dc < 31) ? rp[dr * 31 + dc] : 0.f; biasT[i] = v * LOG2E; bm = fmaxf(bm, fabsf(v)); }
                    bm = wave_max(bm);
                    const float* gq = args.in[opaque_idx(I_NAQG)] + l * 64; const float* gk = args.in[opaque_idx(I_NAKG)] + l * 64;
                    const float mq = wave_max(fabsf(gq[lane])), mk = wave_max(fabsf(gk[lane]));
                    const float negm = -((8.0f * mq * mk + bm) * LOG2E);
                    asm volatile("s_waitcnt lgkmcnt(0)" ::: "memory");
                    for (int rep = 0; rep < REP_NA; ++rep)
                    for (int u = bx; u < BATCH * 128; u += G) att::na_unit(u >> 7, u & 127, h, Zb, MIX, (float*)(ws + WS_RS) + (size_t)(6 + 2 * l) * T, biasT, negm, wl, wsf);
                }
            } else if (s == 10 && EN_CROSS) {
                const float* gq = args.in[opaque_idx(I_MQG)] + l * 128; const float* gk = args.in[opaque_idx(I_MKG)] + l * 128;
                const float mq = wave_max(fmaxf(fabsf(gq[lane]), fabsf(gq[64 + lane]))), mk = wave_max(fmaxf(fabsf(gk[lane]), fabsf(gk[64 + lane])));
                const float negm = -(11.313708498984761f * mq * mk * LOG2E);
                const float qsc = 0.08838834764831845f * LOG2E;
                const bf16_t* KCl = (const bf16_t*)(ws + WS_KC) + (size_t)l * MEMT * 512; const bf16_t* VCl = (const bf16_t*)(ws + WS_VC) + (size_t)l * MEMT * 512;
                for (int rep = 0; rep < REP_CROSS; ++rep)
                for (int u = bx; u < 512; u += G) { const int bhd = u >> 5, qb = u & 31, b = bhd >> 2, hd = bhd & 3;
                    att::dense_unit<128, 128, true>(QC + ((size_t)b * SEQ + qb * 256) * 512 + hd * 128, 512, KCl + (size_t)bhd * 256 * 128, VCl + (size_t)bhd * 256 * 128,
                                                    OC + ((size_t)b * SEQ + qb * 256) * 512 + hd * 128, 512, 256, negm, gq, qsc, lds, wave); }
            } else if ((s == 14 || s == 16) && EN_CONV) {
                const int hf = (s == 16);
                const float* cw = args.in[opaque_idx(I_CONVW)] + (size_t)l * 3 * DFF2; const float* cb = args.in[opaque_idx(I_CONVB)] + (size_t)l * DFF2;
                constexpr int RUN = 8, NCH = DFF / 8, NITEM = (TH / RUN) * NCH;
                for (int it = bx * 512 + TIDX; it < NITEM; it += G * 512) {
                    const int run = it / NCH, nc = it - run * NCH, n0 = nc * 8, t0 = run * RUN;
                    const int s0 = (hf * TH + t0) & (SEQ - 1);
                    const bf16_t* up = Ub + (size_t)t0 * DFF2 + n0;
                    const unsigned z0 = opaque_zero(); const u32x4 zero = (u32x4){z0, z0, z0, z0};
                    u32x4 rg[RUN + 2], rv[RUN + 2];
                    rg[0] = zero; rv[0] = zero; rg[RUN + 1] = zero; rv[RUN + 1] = zero;
                    if (s0 != 0) { rg[0] = *(const u32x4*)(up - DFF2); rv[0] = *(const u32x4*)(up - DFF2 + DFF); }
#pragma unroll
                    for (int i = 0; i < RUN; ++i) { rg[i + 1] = *(const u32x4*)(up + (size_t)i * DFF2); rv[i + 1] = *(const u32x4*)(up + (size_t)i * DFF2 + DFF); }
                    if (s0 + RUN - 1 != SEQ - 1) { rg[RUN + 1] = *(const u32x4*)(up + (size_t)RUN * DFF2); rv[RUN + 1] = *(const u32x4*)(up + (size_t)RUN * DFF2 + DFF); }
                    float w0g[8], w1g[8], w2g[8], bg[8], w0v[8], w1v[8], w2v[8], bv[8];
#pragma unroll
                    for (int e = 0; e < 8; ++e) { w0g[e] = cw[n0 + e]; w1g[e] = cw[DFF2 + n0 + e]; w2g[e] = cw[2 * DFF2 + n0 + e]; bg[e] = cb[n0 + e];
                        w0v[e] = cw[DFF + n0 + e]; w1v[e] = cw[DFF2 + DFF + n0 + e]; w2v[e] = cw[2 * DFF2 + DFF + n0 + e]; bv[e] = cb[DFF + n0 + e]; }
#pragma unroll
                    for (int i = 0; i < RUN; ++i) {
                        float a0[8], a1[8], a2[8], c0[8], c1[8], c2[8], o[8];
                        unpack8(rg[i], a0); unpack8(rg[i + 1], a1); unpack8(rg[i + 2], a2); unpack8(rv[i], c0); unpack8(rv[i + 1], c1); unpack8(rv[i + 2], c2);
#pragma unroll
                        for (int e = 0; e < 8; ++e) { const float gt = a0[e] * w0g[e] + a1[e] * w1g[e] + a2[e] * w2g[e] + bg[e]; const float vl = c0[e] * w0v[e] + c1[e] * w1v[e] + c2[e] * w2v[e] + bv[e];
                            o[e] = gt / (1.0f + __expf(-gt)) * vl; }
                        *(u32x4*)(ACT + (size_t)(t0 + i) * DFF + n0) = pack8(o);
                    }
                }
            }
        }
        if (ph + 1 < args.ph_hi) {
            if (ph == args.ph_lo) { cg::this_grid().sync();
                int ln3; asm volatile("v_mbcnt_lo_u32_b32 %0, -1, 0\n\tv_mbcnt_hi_u32_b32 %0, -1, %0" : "=v"(ln3));
                if (wave == 0 && ln3 == 0) (void)xb_add((unsigned*)(ws + WS_BAR) + XB_XCNT(xcc), 1u); }
            else { int ln2; asm volatile("v_mbcnt_lo_u32_b32 %0, -1, 0\n\tv_mbcnt_hi_u32_b32 %0, -1, %0" : "=v"(ln2));
                   xcd_barrier((unsigned*)(ws + WS_BAR), xcc, bst, wave == 0 && ln2 == 0); }
        }
    }
}

extern "C" void kernel_launch(void* const* d_in, const int* in_sizes, int n_in, void* d_out, int out_size, void* d_ws, size_t ws_size, hipStream_t stream) {
    static int grid = 0;
    if (grid == 0) {
        if (n_in != 27 || in_sizes[0] != T * DM || out_size != T * DM || ws_size < WS_END) { fprintf(stderr, "kernel_launch: unexpected shapes (n_in %d, ws %zu)\n", n_in, ws_size); grid = -1; return; }
        int dev = 0, cus = 0, per_cu = 0;
        hipGetDevice(&dev); hipDeviceGetAttribute(&cus, hipDeviceAttributeMultiprocessorCount, dev);
        if (hipFuncSetAttribute((const void*)mega_fwd, hipFuncAttributeMaxDynamicSharedMemorySize, LDS_BYTES) != hipSuccess) { fprintf(stderr, "kernel_launch: hipFuncSetAttribute failed\n"); grid = -1; return; }
        hipOccupancyMaxActiveBlocksPerMultiprocessor(&per_cu, (const void*)mega_fwd, 512, LDS_BYTES);
        (void)hipGetLastError();
        if (per_cu < 1) per_cu = 1;
        grid = cus * 1;
        if (grid <= 0) grid = 256;
    }
    if (grid < 0) return;
    Args a{};
    for (int i = 0; i < 27; ++i) a.in[i] = (const float*)d_in[i];
    a.out = (float*)d_out; a.ws = (unsigned char*)d_ws;
#ifndef PROBE_MASK
#define PROBE_MASK 0u
#endif
    static const int SEQ15[11] = {1, 2, 3, 4, 5, 7, 9, 10, 11, 13, 17};
    unsigned char pb[96]; int NPH = 0;
    for (int i = 0; i < 96; ++i) pb[i] = 0;
    pb[NPH++] = 255; if (PROBE_MASK & 1u) pb[NPH++] = 255;
    for (int l = 0; l < DEPTH; ++l) for (int i = 0; i < 11; ++i) { const int s = SEQ15[i]; pb[NPH++] = (unsigned char)(l * 32 + s); if ((PROBE_MASK >> s) & 1u) pb[NPH++] = (unsigned char)(l * 32 + s); }
    for (int i = 0; i < 24; ++i) a.prog[i] = (unsigned)pb[4 * i] | ((unsigned)pb[4 * i + 1] << 8) | ((unsigned)pb[4 * i + 2] << 16) | ((unsigned)pb[4 * i + 3] << 24);
#if MK_PER_PHASE
    for (int ph = 0; ph < NPH; ++ph) { a.ph_lo = ph; a.ph_hi = ph + 1; hipLaunchKernelGGL(mega_fwd, dim3(grid), dim3(512), LDS_BYTES, stream, a); }
#else
    a.ph_lo = 0; a.ph_hi = NPH;
    void* kargs[] = {&a};
    hipError_t e = hipLaunchCooperativeKernel((const void*)mega_fwd, dim3(grid), dim3(512), kargs, LDS_BYTES, stream);
    if (e != hipSuccess) fprintf(stderr, "kernel_launch: cooperative launch failed: %s (grid %d)\n", hipGetErrorString(e), grid);
#endif
}
```

```cpp
#include <hip/hip_runtime.h>
#include <hip/hip_cooperative_groups.h>
#include <cstdint>
#include <cstdio>
namespace cg = cooperative_groups;

#ifndef MK_PER_PHASE
#define MK_PER_PHASE 0
#endif


#ifndef EN_GEMM
#define EN_GEMM 1
#endif
#ifndef EN_P1
#define EN_P1 1
#endif
#ifndef EN_P2
#define EN_P2 1
#endif
#ifndef EN_ATT
#define EN_ATT 1
#endif
#ifndef EN_MLA
#define EN_MLA 1
#endif
#ifndef EN_NA
#define EN_NA 1
#endif
#ifndef EN_P3
#define EN_P3 1
#endif
#ifndef EN_CROSS
#define EN_CROSS 1
#endif
#ifndef EN_CONV
#define EN_CONV 1
#endif

#ifndef REP_MLA
#define REP_MLA 1
#endif
#ifndef REP_NA
#define REP_NA 1
#endif
#ifndef REP_CROSS
#define REP_CROSS 1
#endif
#ifndef REP_GEMM0
#define REP_GEMM0 1
#endif
#ifndef REP_EW
#define REP_EW 1
#endif
#ifndef REP_SYNC
#define REP_SYNC 1
#endif
#define LAS __attribute__((address_space(3)))
typedef unsigned short bf16_t;
typedef short bf16x8 __attribute__((ext_vector_type(8)));
typedef short s16x4 __attribute__((ext_vector_type(4)));
typedef float f32x4 __attribute__((ext_vector_type(4)));
typedef float f32x16 __attribute__((ext_vector_type(16)));
typedef unsigned u32x4 __attribute__((ext_vector_type(4)));
typedef unsigned u32x2 __attribute__((ext_vector_type(2)));

constexpr int BATCH = 4, SEQ = 8192, DM = 1024, T = BATCH * SEQ, DEPTH = 2;
constexpr int ZC = 2304;
constexpr int IN_COLS = 2208;
constexpr int OFF_QNA = 0, OFF_KNA = 512, OFF_VNA = 1024, OFF_CQ = 1536, OFF_CKV = 1920, OFF_KR = 2176;
constexpr int DFF = 2816, DFF2 = 5632;
constexpr int MEMT = BATCH * 256;
constexpr float EPS = 1e-6f;
constexpr float LOG2E = 1.4426950408889634f;
constexpr int TH = T / 2;

constexpr size_t MiB = 1u << 20;
constexpr size_t WS_TAB = 0;
constexpr size_t WS_BAR = 512 * 1024, BAR_BYTES = 16384;
constexpr size_t WS_W = 1 * MiB;
constexpr size_t W_IN = 0, W_UQ = W_IN + (size_t)ZC * 1024 * 2, W_UKV = W_UQ + (size_t)768 * 384 * 2, W_OUT = W_UKV + (size_t)1024 * 256 * 2,
                 W_MQ = W_OUT + (size_t)1024 * 1024 * 2, W_MKV = W_MQ + (size_t)512 * 1024 * 2, W_MO = W_MKV + (size_t)1024 * 1024 * 2,
                 W_UP = W_MO + (size_t)1024 * 512 * 2, W_DN = W_UP + (size_t)DFF2 * 1024 * 2, W_LAYER = W_DN + (size_t)1024 * DFF * 2;
static_assert(WS_W + 2 * W_LAYER <= 60 * MiB, "weights");
constexpr size_t WS_MEMN = 60 * MiB, WS_KVCR = 64 * MiB, WS_KC = 68 * MiB, WS_VC = 70 * MiB;
constexpr size_t WS_XN = 72 * MiB;
constexpr size_t WS_QA = 72 * MiB;
constexpr size_t WS_Z = 136 * MiB;
constexpr size_t WS_MIX = 328 * MiB;
constexpr size_t WS_QM = 280 * MiB, WS_KVM = 328 * MiB;
constexpr size_t WS_OA = 280 * MiB, WS_OB = 312 * MiB;
constexpr size_t WS_KA = 392 * MiB, WS_VA = 440 * MiB;
constexpr size_t WS_QC = 136 * MiB, WS_OC = 168 * MiB;
constexpr size_t WS_U = 136 * MiB, WS_ACT = 136 * MiB;
constexpr size_t WS_RS = 472 * MiB;
constexpr size_t WS_END = 474 * MiB;

constexpr int LDS_BYTES = 150 * 1024;
constexpr int LDS_MISC = LDS_BYTES - 64;

__device__ __forceinline__ unsigned pk2(float lo, float hi) { unsigned r; asm("v_cvt_pk_bf16_f32 %0, %1, %2" : "=v"(r) : "v"(lo), "v"(hi)); return r; }
__device__ __forceinline__ float bf_lo(unsigned u) { return __uint_as_float(u << 16); }
__device__ __forceinline__ float bf_hi(unsigned u) { return __uint_as_float(u & 0xffff0000u); }
template <int O> __device__ __forceinline__ float xorl(float v) {
    if constexpr (O < 32) return __uint_as_float((unsigned)__builtin_amdgcn_ds_swizzle((int)__float_as_uint(v), (O << 10) | 0x1f));
    else { auto rr = __builtin_amdgcn_permlane32_swap(__float_as_uint(v), __float_as_uint(v), false, false); return __uint_as_float((__float_as_uint(v) == rr[0]) ? rr[1] : rr[0]); }
}
template <int CTRL> __device__ __forceinline__ float dppf(float old, float srcv) {
    return __int_as_float(__builtin_amdgcn_update_dpp(__float_as_int(old), __float_as_int(srcv), CTRL, 0xf, 0xf, false));
}
template <int CTRL> __device__ __forceinline__ f32x4 rot4(f32x4 s) {
    f32x4 r;
#pragma unroll
    for (int e = 0; e < 4; ++e) r[e] = __int_as_float(__builtin_amdgcn_mov_dpp(__float_as_int(s[e]), CTRL, 0xf, 0xf, false));
    return r;
}
template <int CTRL> __device__ __forceinline__ f32x4 dpp4(f32x4 old, f32x4 s) { f32x4 r; r[0] = dppf<CTRL>(old[0], s[0]); r[1] = dppf<CTRL>(old[1], s[1]); r[2] = dppf<CTRL>(old[2], s[2]); r[3] = dppf<CTRL>(old[3], s[3]); return r; }
__device__ __forceinline__ float att_swap_add(float v) {
    auto rr = __builtin_amdgcn_permlane32_swap(__float_as_uint(v), __float_as_uint(v), false, false);
    return __uint_as_float(rr[0]) + __uint_as_float(rr[1]);
}
__device__ __forceinline__ float wave_sum(float v) {
    v += xorl<1>(v); v += xorl<2>(v); v += xorl<4>(v); v += xorl<8>(v); v += xorl<16>(v);
    auto rr = __builtin_amdgcn_permlane32_swap(__float_as_uint(v), __float_as_uint(v), false, false);
    return __uint_as_float(rr[0]) + __uint_as_float(rr[1]);
}
__device__ __forceinline__ float wave_max(float v) {
    v = fmaxf(v, xorl<1>(v)); v = fmaxf(v, xorl<2>(v)); v = fmaxf(v, xorl<4>(v)); v = fmaxf(v, xorl<8>(v)); v = fmaxf(v, xorl<16>(v));
    auto rr = __builtin_amdgcn_permlane32_swap(__float_as_uint(v), __float_as_uint(v), false, false);
    return fmaxf(__uint_as_float(rr[0]), __uint_as_float(rr[1]));
}
__device__ __forceinline__ void unpack8(const u32x4 v, float* f) {
    f[0] = bf_lo(v.x); f[1] = bf_hi(v.x); f[2] = bf_lo(v.y); f[3] = bf_hi(v.y); f[4] = bf_lo(v.z); f[5] = bf_hi(v.z); f[6] = bf_lo(v.w); f[7] = bf_hi(v.w);
}
__device__ __forceinline__ u32x4 pack8(const float* f) { u32x4 o; o.x = pk2(f[0], f[1]); o.y = pk2(f[2], f[3]); o.z = pk2(f[4], f[5]); o.w = pk2(f[6], f[7]); return o; }
__device__ __forceinline__ float sumsq8(const u32x4 v) { float f[8]; unpack8(v, f); float s = 0.f;
#pragma unroll
    for (int e = 0; e < 8; ++e) s += f[e] * f[e];
    return s; }

namespace pg8 {
constexpr int BM = 256, BK = 64, HALF = 128, HTB = HALF * BK * 2, STAGE_BYTES = 8 * HTB, NXCD = 8, WGM = 8;
__host__ __device__ __forceinline__ int lds_byte(int r, int c) { const int st = (r >> 4) * 2 + (c >> 5), rr = r & 15, cc = c & 31, ob = rr * 64 + cc * 2; return st * 1024 + (ob ^ (((ob >> 9) & 1) << 5)); }
__host__ __device__ __forceinline__ void stage_rc(int b, int& R, int& C) { const int st = b / 1024, sb = b % 1024, swz = sb ^ (((sb >> 9) & 1) << 5); R = (st >> 1) * 16 + swz / 64; C = (st & 1) * 32 + (swz % 64) / 2; }
__host__ __device__ __forceinline__ int perm32(int rho) { const int n = rho >> 4, i = rho & 15; return 8 * (i >> 2) + 4 * n + (i & 3); }

__device__ __forceinline__ const char* uniform_cptr(const char* p) {
    const unsigned long long v = (unsigned long long)p;
    const unsigned lo = __builtin_amdgcn_readfirstlane((unsigned)v), hi = __builtin_amdgcn_readfirstlane((unsigned)(v >> 32));
    return (const char*)(((unsigned long long)hi << 32) | lo);
}
struct Unit { int pm, pn; };
struct Gemm { const bf16_t* A; const bf16_t* Bt; int M, N, K, lda; const float* mida; const float* midb; int trows, pad_; };

struct StaticOrder {
    int nM, nN, nwg, G, c;
    __device__ void init(int M, int N, int G_, int c_) { nM = M / BM; nN = N / BM; nwg = nM * nN; G = G_; c = c_; }
    __device__ bool next(int i, Unit& u) const {
        const long L = (long)i * G + c; if (L >= nwg) return false;
        int wgid = (int)L; { const int q = nwg / NXCD, r = nwg % NXCD, xcd = wgid % NXCD, off = wgid / NXCD; wgid = (xcd < r ? xcd * (q + 1) : r * (q + 1) + (xcd - r) * q) + off; }
        const int nig = WGM * nN, gid = wgid / nig, fm = gid * WGM, gsz = (nM - fm) < WGM ? (nM - fm) : WGM;
        u.pm = fm + ((wgid % nig) % gsz); u.pn = (wgid % nig) / gsz; return true;
    }
};

struct EpiDesc { int mode, ldc; void* dst; const float* base; float* rs; bf16_t* xb; const float* rs2; };
#define GAS __attribute__((address_space(1)))
struct EpiUni {
    static constexpr bool PERM = true, PREFETCH_RS = true;
    const LAS EpiDesc* d;
    __device__ __forceinline__ void operator()(f32x4 (&acc)[2][2][4][2], const Unit& u, int wr, int wc, int fr, int fq, const float (&rsv)[8]) const {
        const int mode = __builtin_amdgcn_readfirstlane(d->mode), ldc = __builtin_amdgcn_readfirstlane(d->ldc);
        GAS float* const rs = (GAS float*)d->rs;
        const int row0 = u.pm * BM + wr * 64 + fr; const int col0 = u.pn * BM + wc * 32 + 8 * fq;
        if (mode == 0) {
            GAS bf16_t* const O = (GAS bf16_t*)d->dst;
            float sc[2][4];
#pragma unroll
            for (int ai = 0; ai < 2; ++ai)
#pragma unroll
                for (int m = 0; m < 4; ++m) sc[ai][m] = rsv[ai * 4 + m];
            if (rs) {
#pragma unroll
                for (int ai = 0; ai < 2; ++ai)
#pragma unroll
                    for (int m = 0; m < 4; ++m) sc[ai][m] = 1.0f / sqrtf(sc[ai][m] * (1.0f / 1024.0f) + EPS);
            } else {
#pragma unroll
                for (int ai = 0; ai < 2; ++ai)
#pragma unroll
                    for (int m = 0; m < 4; ++m) sc[ai][m] = 1.0f;
            }
#pragma unroll
            for (int ai = 0; ai < 2; ++ai)
#pragma unroll
                for (int m = 0; m < 4; ++m) { const int row = row0 + ai * HALF + m * 16; GAS bf16_t* rowp = O + (size_t)row * ldc + col0;
#pragma unroll
                    for (int bj = 0; bj < 2; ++bj) { const f32x4 v0 = acc[ai][bj][m][0] * sc[ai][m], v1 = acc[ai][bj][m][1] * sc[ai][m];
                        u32x4 w; w.x = pk2(v0[0], v0[1]); w.y = pk2(v0[2], v0[3]); w.z = pk2(v1[0], v1[1]); w.w = pk2(v1[2], v1[3]);
                        *(GAS u32x4*)(rowp + bj * HALF) = w; } }
        } else {
            GAS float* const out = (GAS float*)d->dst; const GAS float* const base = (const GAS float*)d->base; GAS bf16_t* const xb = (GAS bf16_t*)d->xb; const GAS float* const rs2 = (const GAS float*)d->rs2;
#pragma unroll
            for (int ab = 0; ab < 4; ++ab) { const int ai = ab >> 1, mb = (ab & 1) * 2;
                f32x4 pre[2][2][2];
#pragma unroll
                for (int mm = 0; mm < 2; ++mm) { const size_t off = (size_t)(row0 + ai * HALF + (mb + mm) * 16) * ldc + col0;
#pragma unroll
                    for (int bj = 0; bj < 2; ++bj) { pre[mm][bj][0] = *(const GAS f32x4*)(base + off + bj * HALF); pre[mm][bj][1] = *(const GAS f32x4*)(base + off + bj * HALF + 4); } }
#pragma unroll
                for (int mm = 0; mm < 2; ++mm) { const int m = mb + mm; const int row = row0 + ai * HALF + m * 16; const size_t off = (size_t)row * ldc + col0; float ss = 0.f;
                    float s2 = 1.0f; if (rs2) s2 = 1.0f / sqrtf(rs2[row] * (1.0f / 512.0f) + EPS);
#pragma unroll
                    for (int bj = 0; bj < 2; ++bj) {
                        const f32x4 o0 = pre[mm][bj][0] + acc[ai][bj][m][0] * s2, o1 = pre[mm][bj][1] + acc[ai][bj][m][1] * s2;
                        *(GAS f32x4*)(out + off + bj * HALF) = o0; *(GAS f32x4*)(out + off + bj * HALF + 4) = o1;
                        if (xb) { u32x4 w; w.x = pk2(o0[0], o0[1]); w.y = pk2(o0[2], o0[3]); w.z = pk2(o1[0], o1[1]); w.w = pk2(o1[2], o1[3]); *(GAS u32x4*)(xb + off + bj * HALF) = w;
                            ss += (o0[0] * o0[0] + o0[1] * o0[1]) + (o0[2] * o0[2] + o0[3] * o0[3]) + (o1[0] * o1[0] + o1[1] * o1[1]) + (o1[2] * o1[2] + o1[3] * o1[3]); } }
                    if (xb) { ss += xorl<16>(ss); ss = att_swap_add(ss); if (fq == 0) __builtin_amdgcn_global_atomic_fadd_f32(rs + row, ss); } }
                asm volatile("" ::: "memory");
            }
        }
    }
};

struct EpiConv {
    static constexpr bool PERM = true, PREFETCH_RS = false;
    const LAS EpiDesc* d;
    __device__ __forceinline__ void operator()(f32x4 (&acc)[2][2][4][2], const Unit& u, int wr, int wc, int fr, int fq, const float (&rsv)[8]) const {
            GAS bf16_t* const ACTp = (GAS bf16_t*)d->dst; const GAS float* const cw = (const GAS float*)d->base; const GAS float* const cbp = (const GAS float*)d->rs2;
            const int tr0 = wr * 64 + fr; const int t0 = u.pm * 254 - 1 + tr0;
#pragma unroll
            for (int ai = 0; ai < 2; ++ai)
#pragma unroll
                for (int m = 0; m < 4; ++m) { const float sc = 1.0f / sqrtf(rsv[ai * 4 + m] * (1.0f / 1024.0f) + EPS);
#pragma unroll
                    for (int bj = 0; bj < 2; ++bj)
#pragma unroll
                        for (int n = 0; n < 2; ++n) acc[ai][bj][m][n] = acc[ai][bj][m][n] * sc; }
            LAS float* const xch = (LAS float*)((LAS unsigned char*)d + 768);
            const int w8 = wr * 4 + wc;
            if (fr == 0) {
#pragma unroll
                for (int ai = 0; ai < 2; ++ai)
#pragma unroll
                    for (int bj = 0; bj < 2; ++bj) { LAS f32x4* p = (LAS f32x4*)(xch + ((((w8 * 2 + ai) * 2 + 0) * 2 + bj) * 4 + fq) * 8); p[0] = acc[ai][bj][0][0]; p[1] = acc[ai][bj][0][1]; }
            }
            if (fr == 15) {
#pragma unroll
                for (int ai = 0; ai < 2; ++ai)
#pragma unroll
                    for (int bj = 0; bj < 2; ++bj) { LAS f32x4* p = (LAS f32x4*)(xch + ((((w8 * 2 + ai) * 2 + 1) * 2 + bj) * 4 + fq) * 8); p[0] = acc[ai][bj][3][0]; p[1] = acc[ai][bj][3][1]; }
            }
            LAS float* const cwl = xch + 2048;
#pragma unroll
            for (int k = 0; k < 2; ++k) { const int idx = w8 * 64 + fq * 16 + fr + 512 * k, bjx = idx >> 9, arr = (idx >> 7) & 3, col = idx & 127;
                const GAS float* sp_ = ((arr < 3) ? (cw + arr * DFF2) : cbp) + bjx * DFF + u.pn * 128 + col; cwl[idx] = *sp_; }
            asm volatile("s_waitcnt vmcnt(0) lgkmcnt(0)" ::: "memory"); __builtin_amdgcn_s_barrier(); asm volatile("" ::: "memory");
            const int colg = u.pn * 128 + wc * 32 + fq * 8; const int cl = wc * 32 + fq * 8;
#pragma unroll
            for (int n = 0; n < 2; ++n) {
                const int c4 = colg + 4 * n;
                const LAS f32x4* const wlg = (const LAS f32x4*)(cwl + cl + 4 * n); const LAS f32x4* const wlv = (const LAS f32x4*)(cwl + 512 + cl + 4 * n);
                const f32x4 w0g = wlg[0], w1g = wlg[32], w2g = wlg[64], bg = wlg[96], w0v = wlv[0], w1v = wlv[32], w2v = wlv[64], bv = wlv[96];
#pragma unroll
                for (int ai = 0; ai < 2; ++ai) {
                    const int pw = (wr == 1) ? wc : ((ai == 1) ? 4 + wc : -1), pai = (wr == 1) ? ai : 0;
                    const int nw = (wr == 0) ? 4 + wc : ((ai == 0) ? wc : -1), nai = (wr == 0) ? ai : 1;
                    f32x4 pHg = (f32x4){0.f, 0.f, 0.f, 0.f}, pHv = pHg, nHg = pHg, nHv = pHg;
                    if (pw >= 0) { pHg = *(const LAS f32x4*)(xch + ((((pw * 2 + pai) * 2 + 1) * 2 + 0) * 4 + fq) * 8 + 4 * n); pHv = *(const LAS f32x4*)(xch + ((((pw * 2 + pai) * 2 + 1) * 2 + 1) * 4 + fq) * 8 + 4 * n); }
                    if (nw >= 0) { nHg = *(const LAS f32x4*)(xch + ((((nw * 2 + nai) * 2 + 0) * 2 + 0) * 4 + fq) * 8 + 4 * n); nHv = *(const LAS f32x4*)(xch + ((((nw * 2 + nai) * 2 + 0) * 2 + 1) * 4 + fq) * 8 + 4 * n); }
#pragma unroll
                    for (int m = 0; m < 4; ++m) {
                        const int t = t0 + ai * HALF + m * 16, rho = tr0 + ai * HALF + m * 16, sp = t & (SEQ - 1);
                        int spl = sp; asm volatile("" : "+v"(spl));
                        const float mp = (spl == 0) ? 0.f : 1.f, mn = (spl == SEQ - 1) ? 0.f : 1.f;
                        float o[4];
                        {
                            const f32x4 cg = acc[ai][0][m][n];
                            const f32x4 fp = (m == 0) ? pHg : rot4<0x121>(acc[ai][0][m == 0 ? 0 : m - 1][n]);
                            const f32x4 fn = (m == 3) ? nHg : rot4<0x12F>(acc[ai][0][m == 3 ? 3 : m + 1][n]);
                            const f32x4 pg = dpp4<0x111>(fp, cg), ng = dpp4<0x101>(fn, cg);
                            const f32x4 gt = (pg * w0g) * mp + cg * w1g + (ng * w2g) * mn + bg;
#pragma unroll
                            for (int e = 0; e < 4; ++e) o[e] = gt[e] * __builtin_amdgcn_rcpf(1.0f + __builtin_amdgcn_exp2f(-1.4426950408889634f * gt[e]));
                        }
                        __builtin_amdgcn_sched_barrier(0);
                        {
                            const f32x4 cv = acc[ai][1][m][n];
                            const f32x4 fp = (m == 0) ? pHv : rot4<0x121>(acc[ai][1][m == 0 ? 0 : m - 1][n]);
                            const f32x4 fn = (m == 3) ? nHv : rot4<0x12F>(acc[ai][1][m == 3 ? 3 : m + 1][n]);
                            const f32x4 pv = dpp4<0x111>(fp, cv), nv = dpp4<0x101>(fn, cv);
                            const f32x4 vl = (pv * w0v) * mp + cv * w1v + (nv * w2v) * mn + bv;
#pragma unroll
                            for (int e = 0; e < 4; ++e) o[e] *= vl[e];
                        }
                        if (rho >= 1 && rho <= 254 && t < T) { u32x2 w; w.x = pk2(o[0], o[1]); w.y = pk2(o[2], o[3]); *(GAS u32x2*)(ACTp + (size_t)t * DFF + c4) = w; }
                        __builtin_amdgcn_sched_barrier(0);
                    }
                }
            }
    }
};

template <class Epi, class Sched>
__device__ __forceinline__ void gemm_phase(LAS unsigned char* lds, const LAS Gemm* gd, const Sched& S, const Epi& E, const int wid) {
    int lane; asm volatile("v_mbcnt_lo_u32_b32 %0, -1, 0\n\tv_mbcnt_hi_u32_b32 %0, -1, %0" : "=v"(lane));
    const int tid = wid * 64 + lane, wr = wid >> 2, wc = wid & 3, fr = lane & 15, fq = lane >> 4;
    const int K = __builtin_amdgcn_readfirstlane(gd->K), nt = K / BK, lda = __builtin_amdgcn_readfirstlane(gd->lda);
#define GD_A (uniform_cptr((const char*)gd->A))
#define GD_B (uniform_cptr((const char*)gd->Bt))
    unsigned voffA[2], voffB[2];
#pragma unroll
    for (int i = 0; i < 2; ++i) { int R, C; stage_rc(tid * 16 + i * 8192, R, C); const int Rb = Epi::PERM ? ((R & ~31) + perm32(R & 31)) : R;
        voffA[i] = (unsigned)(R * lda + C) * 2u; voffB[i] = (unsigned)(Rb * K + C) * 2u; }
    constexpr unsigned kstep = BK * 2;
    const unsigned hstepA = (unsigned)HALF * lda * 2, hstepB = (unsigned)HALF * K * 2;
    const int trows = __builtin_amdgcn_readfirstlane(gd->trows);
    const unsigned tstepA = (unsigned)trows * lda * 2, tstepB = 2 * hstepB;
    const unsigned ldsw = (unsigned)wid * 1024u;
    const int aoff = lds_byte(wr * 64 + fr, fq * 8), boff = lds_byte(wc * 32 + fr, fq * 8);
#define PG8_SA(b, h) (((b) * 2 + (h)) * HTB)
#define PG8_SB(b, h) ((4 + (b) * 2 + (h)) * HTB)
#define PG8_STAGE(bufoff, gbase, voff) do { _Pragma("unroll") for (int _i = 0; _i < 2; ++_i) \
        __builtin_amdgcn_global_load_lds((const unsigned*)((const char*)(gbase) + (voff)[_i]), (LAS unsigned*)(lds + (bufoff) + ldsw + _i * 8192), 16, 0, 0); } while (0)
#define PG8_LDA(dst, b, h) do { _Pragma("unroll") for (int m = 0; m < 4; ++m) _Pragma("unroll") for (int k = 0; k < 2; ++k) dst[m][k] = *(const LAS bf16x8*)(lds + PG8_SA(b, h) + aoff + m * 2048 + k * 1024); } while (0)
#define PG8_LDB(dst, b, h) do { _Pragma("unroll") for (int n = 0; n < 2; ++n) _Pragma("unroll") for (int k = 0; k < 2; ++k) dst[n][k] = *(const LAS bf16x8*)(lds + PG8_SB(b, h) + boff + n * 2048 + k * 1024); } while (0)
#define PG8_MMA(ai, bj, At, Bt) do { __builtin_amdgcn_s_setprio(1); _Pragma("unroll") for (int m = 0; m < 4; ++m) _Pragma("unroll") for (int n = 0; n < 2; ++n) _Pragma("unroll") for (int k = 0; k < 2; ++k) \
        acc[ai][bj][m][n] = __builtin_amdgcn_mfma_f32_16x16x32_bf16(Bt[n][k], At[m][k], acc[ai][bj][m][n], 0, 0, 0); __builtin_amdgcn_s_setprio(0); } while (0)
#define PG8_WAIT_V(n) asm volatile("s_waitcnt vmcnt(" #n ")" ::: "memory")
#define PG8_WAIT_L(n) asm volatile("s_waitcnt lgkmcnt(" #n ")" ::: "memory")
#define PG8_BAR __builtin_amdgcn_s_barrier()
#define PG8_SCHED __builtin_amdgcn_sched_barrier(0)
    Unit cur, nxt; int ui = 0;
    if (!S.next(0, cur)) return;
    const GAS float* const rsp = (E.d->mode != 1) ? (const GAS float*)uniform_cptr((const char*)E.d->rs) : nullptr;
    float rsv[8];
#pragma unroll
    for (int q = 0; q < 8; ++q) rsv[q] = 1024.0f;
    f32x4 acc[2][2][4][2];
#pragma unroll
    for (int a = 0; a < 2; ++a)
#pragma unroll
        for (int b = 0; b < 2; ++b)
#pragma unroll
            for (int m = 0; m < 4; ++m)
#pragma unroll
                for (int n = 0; n < 2; ++n) acc[a][b][m][n] = (f32x4){0.f, 0.f, 0.f, 0.f};
    bf16x8 At[4][2], B0[2][2], B1[2][2];
    const char* cA = GD_A + (unsigned)cur.pm * tstepA; const char* cB = GD_B + (unsigned)cur.pn * tstepB;
    PG8_STAGE(PG8_SB(0, 0), cB, voffB); PG8_STAGE(PG8_SB(0, 1), cB + hstepB, voffB); PG8_STAGE(PG8_SA(0, 0), cA, voffA); PG8_STAGE(PG8_SA(0, 1), cA + hstepA, voffA);
    if (wr == 1) PG8_BAR;
    PG8_WAIT_V(2); PG8_BAR;
    PG8_STAGE(PG8_SB(1, 0), cB + kstep, voffB); PG8_STAGE(PG8_SA(1, 0), cA + kstep, voffA); PG8_STAGE(PG8_SB(1, 1), cB + hstepB + kstep, voffB);
    PG8_WAIT_V(6); PG8_BAR;
    for (;;) {
        const bool has_next = S.next(ui + 1, nxt);
        const char* nA = has_next ? GD_A + (unsigned)nxt.pm * tstepA : cA; const char* nB = has_next ? GD_B + (unsigned)nxt.pn * tstepB : cB;
        for (int t = 0; t < nt; t += 2) {
            if (t == (nt >> 1) && gd->mida != nullptr) {
                const int rbase = cur.pm * BM + wr * 64 + fr;
#pragma unroll
                for (int a = 0; a < 2; ++a)
#pragma unroll
                    for (int m = 0; m < 4; ++m) { const int row = rbase + a * HALF + m * 16;
                        const float qa = ((const GAS float*)uniform_cptr((const char*)gd->mida))[row], qb = ((const GAS float*)uniform_cptr((const char*)gd->midb))[row];
                        const float ratio = sqrtf((qb * (1.0f / 512.0f) + EPS) / (qa * (1.0f / 512.0f) + EPS));
#pragma unroll
                        for (int b = 0; b < 2; ++b)
#pragma unroll
                            for (int n = 0; n < 2; ++n) acc[a][b][m][n] = acc[a][b][m][n] * ratio; }
            }
            const bool last = (t == nt - 2);
            if (Epi::PREFETCH_RS && last && rsp != nullptr) {
                const int rb = cur.pm * trows + (trows == 254 ? -1 : 0) + wr * 64 + fr;
#pragma unroll
                for (int q = 0; q < 8; ++q) rsv[q] = rsp[rb + (q >> 2) * HALF + (q & 3) * 16];
            }
            const char* a1 = cA + (unsigned)(t + 1) * kstep;
            const char* a2 = last ? nA : cA + (unsigned)(t + 2) * kstep; const char* b2 = last ? nB : cB + (unsigned)(t + 2) * kstep;
            const char* a3 = a2 + kstep; const char* b3 = b2 + kstep;
            PG8_LDB(B0, 0, 0); PG8_LDB(B1, 0, 1); PG8_SCHED; PG8_LDA(At, 0, 0); PG8_STAGE(PG8_SA(1, 1), a1 + hstepA, voffA);
            PG8_WAIT_V(8); PG8_WAIT_L(0); PG8_BAR; PG8_MMA(0, 0, At, B0); PG8_MMA(0, 1, At, B1); PG8_BAR; PG8_SCHED;
            PG8_LDA(At, 0, 1); PG8_STAGE(PG8_SB(0, 0), b2, voffB); PG8_STAGE(PG8_SB(0, 1), b2 + hstepB, voffB); PG8_STAGE(PG8_SA(0, 0), a2, voffA);
            PG8_WAIT_V(8); PG8_WAIT_L(0); PG8_BAR; PG8_MMA(1, 0, At, B0); PG8_MMA(1, 1, At, B1); PG8_BAR; PG8_SCHED;
            PG8_LDB(B0, 1, 0); PG8_LDB(B1, 1, 1); PG8_SCHED; PG8_LDA(At, 1, 0); PG8_STAGE(PG8_SA(0, 1), a2 + hstepA, voffA);
            PG8_WAIT_V(8); PG8_WAIT_L(0); PG8_BAR; PG8_MMA(0, 0, At, B0); PG8_MMA(0, 1, At, B1); PG8_BAR; PG8_SCHED;
            PG8_LDA(At, 1, 1); PG8_STAGE(PG8_SB(1, 0), b3, voffB); PG8_STAGE(PG8_SB(1, 1), b3 + hstepB, voffB); PG8_STAGE(PG8_SA(1, 0), a3, voffA);
            PG8_WAIT_V(8); PG8_WAIT_L(0); PG8_BAR; PG8_MMA(1, 0, At, B0); PG8_MMA(1, 1, At, B1); PG8_BAR; PG8_SCHED;
        }
        if (wr == 0) PG8_BAR;
        if constexpr (Epi::PREFETCH_RS) { E(acc, cur, wr, wc, fr, fq, rsv); }
        else { float rl[8]; const int rb = cur.pm * trows + (trows == 254 ? -1 : 0) + wr * 64 + fr;
#pragma unroll
            for (int q = 0; q < 8; ++q) rl[q] = rsp[rb + (q >> 2) * HALF + (q & 3) * 16];
            E(acc, cur, wr, wc, fr, fq, rl); }
        if (!has_next) break;
#pragma unroll
        for (int a = 0; a < 2; ++a)
#pragma unroll
            for (int b = 0; b < 2; ++b)
#pragma unroll
                for (int m = 0; m < 4; ++m)
#pragma unroll
                    for (int n = 0; n < 2; ++n) acc[a][b][m][n] = (f32x4){0.f, 0.f, 0.f, 0.f};
        cur = nxt; cA = nA; cB = nB; ++ui;
        if (wr == 1) PG8_BAR;
    }
    PG8_WAIT_V(0);
    PG8_BAR;
#undef GD_A
#undef GD_B
#undef PG8_SA
#undef PG8_SB
#undef PG8_STAGE
#undef PG8_LDA
#undef PG8_LDB
#undef PG8_MMA
#undef PG8_WAIT_V
#undef PG8_WAIT_L
#undef PG8_BAR
#undef PG8_SCHED
}
}

namespace att {
#define KSWZ(row, colB) ((row) * 256 + ((colB) ^ (((row) & 7) << 4)))
#define SBAR() __builtin_amdgcn_sched_barrier(0)
__device__ __forceinline__ int crow(int r, int hi) { return (r & 3) + 8 * (r >> 2) + 4 * hi; }
template <int NDV> __device__ __forceinline__ int v_st(int k, int c) { const int kk = (k & ~0xC) | ((k & 4) << 1) | ((k & 8) >> 1); return ((kk >> 3) * NDV + (c >> 5)) * 512 + ((kk & 7) * 32 + (c & 31)) * 2; }
__device__ __forceinline__ int v_rd_base(int lane) { return ((lane & 3) << 3) | (((lane >> 2) & 3) << 6) | (((lane >> 4) & 1) << 5) | (((lane >> 5) & 1) << 8); }
template <int OFF> __device__ __forceinline__ s16x4 tr_read(int vb) {
    s16x4 r; asm volatile("ds_read_b64_tr_b16 %0, %1 offset:%2" : "=&v"(r) : "v"(vb), "i"(OFF) : "memory"); return r;
}
template <int NDV, int D0> __device__ __forceinline__ void pv_one(f32x16& od, int vb, bf16x8 pa0, bf16x8 pa1, bf16x8 pa2, bf16x8 pa3) {
    constexpr int KS = 2 * NDV * 512, HF = NDV * 512, B0 = D0 * 512;
    const s16x4 l0 = tr_read<B0>(vb), h0 = tr_read<B0 + HF>(vb), l1 = tr_read<B0 + KS>(vb), h1 = tr_read<B0 + KS + HF>(vb);
    const s16x4 l2 = tr_read<B0 + 2 * KS>(vb), h2 = tr_read<B0 + 2 * KS + HF>(vb), l3 = tr_read<B0 + 3 * KS>(vb), h3 = tr_read<B0 + 3 * KS + HF>(vb);
    asm volatile("s_waitcnt lgkmcnt(0)" ::: "memory"); SBAR();
#define PK(L, H) (bf16x8){L[0], L[1], L[2], L[3], H[0], H[1], H[2], H[3]}
    od = __builtin_amdgcn_mfma_f32_32x32x16_bf16(pa0, PK(l0, h0), od, 0, 0, 0);
    od = __builtin_amdgcn_mfma_f32_32x32x16_bf16(pa1, PK(l1, h1), od, 0, 0, 0);
    od = __builtin_amdgcn_mfma_f32_32x32x16_bf16(pa2, PK(l2, h2), od, 0, 0, 0);
    od = __builtin_amdgcn_mfma_f32_32x32x16_bf16(pa3, PK(l3, h3), od, 0, 0, 0);
#undef PK
}
template <int NDV> __device__ __forceinline__ void pv_all(f32x16* o, int vb, bf16x8 pa0, bf16x8 pa1, bf16x8 pa2, bf16x8 pa3) {
    if constexpr (NDV == 2) {
        constexpr int KS = 2 * NDV * 512, HF = NDV * 512;
        const s16x4 l0 = tr_read<0>(vb), h0 = tr_read<HF>(vb), m0 = tr_read<512>(vb), n0 = tr_read<512 + HF>(vb);
        const s16x4 l1 = tr_read<KS>(vb), h1 = tr_read<KS + HF>(vb), m1 = tr_read<KS + 512>(vb), n1 = tr_read<KS + 512 + HF>(vb);
        const s16x4 l2 = tr_read<2 * KS>(vb), h2 = tr_read<2 * KS + HF>(vb), m2 = tr_read<2 * KS + 512>(vb), n2 = tr_read<2 * KS + 512 + HF>(vb);
        const s16x4 l3 = tr_read<3 * KS>(vb), h3 = tr_read<3 * KS + HF>(vb), m3 = tr_read<3 * KS + 512>(vb), n3 = tr_read<3 * KS + 512 + HF>(vb);
        asm volatile("s_waitcnt lgkmcnt(0)" ::: "memory"); SBAR();
#define PK(L, H) (bf16x8){L[0], L[1], L[2], L[3], H[0], H[1], H[2], H[3]}
        o[0] = __builtin_amdgcn_mfma_f32_32x32x16_bf16(pa0, PK(l0, h0), o[0], 0, 0, 0); o[1] = __builtin_amdgcn_mfma_f32_32x32x16_bf16(pa0, PK(m0, n0), o[1], 0, 0, 0);
        o[0] = __builtin_amdgcn_mfma_f32_32x32x16_bf16(pa1, PK(l1, h1), o[0], 0, 0, 0); o[1] = __builtin_amdgcn_mfma_f32_32x32x16_bf16(pa1, PK(m1, n1), o[1], 0, 0, 0);
        o[0] = __builtin_amdgcn_mfma_f32_32x32x16_bf16(pa2, PK(l2, h2), o[0], 0, 0, 0); o[1] = __builtin_amdgcn_mfma_f32_32x32x16_bf16(pa2, PK(m2, n2), o[1], 0, 0, 0);
        o[0] = __builtin_amdgcn_mfma_f32_32x32x16_bf16(pa3, PK(l3, h3), o[0], 0, 0, 0); o[1] = __builtin_amdgcn_mfma_f32_32x32x16_bf16(pa3, PK(m3, n3), o[1], 0, 0, 0);
#undef PK
    } else {
        pv_one<NDV, 0>(o[0], vb, pa0, pa1, pa2, pa3); pv_one<NDV, 1>(o[1], vb, pa0, pa1, pa2, pa3);
        pv_one<NDV, 2>(o[2], vb, pa0, pa1, pa2, pa3); pv_one<NDV, 3>(o[3], vb, pa0, pa1, pa2, pa3);
    }
}
__device__ __forceinline__ void pack_p(const f32x16& p0, const f32x16& p1, bf16x8& pa0, bf16x8& pa1, bf16x8& pa2, bf16x8& pa3) {
#define PK4(P, BASE, OUT) do { unsigned a0 = pk2(P[BASE + 0], P[BASE + 1]), a1 = pk2(P[BASE + 2], P[BASE + 3]);   \
    unsigned b0 = pk2(P[BASE + 4], P[BASE + 5]), b1 = pk2(P[BASE + 6], P[BASE + 7]);                              \
    auto r0 = __builtin_amdgcn_permlane32_swap(a0, b0, false, false); auto r1 = __builtin_amdgcn_permlane32_swap(a1, b1, false, false); \
    u32x4 w = {r0[0], r1[0], r0[1], r1[1]}; OUT = __builtin_bit_cast(bf16x8, w); } while (0)
    PK4(p0, 0, pa0); PK4(p0, 8, pa1); PK4(p1, 0, pa2); PK4(p1, 8, pa3);
#undef PK4
}
__device__ __forceinline__ float swap_add(float v) {
    auto rr = __builtin_amdgcn_permlane32_swap(__float_as_uint(v), __float_as_uint(v), false, false);
    return __uint_as_float(rr[0]) + __uint_as_float(rr[1]);
}

template <int DQK, int DV, bool QNORM, bool ROPE = false>
__device__ __forceinline__ void dense_unit(const bf16_t* Qb, int ldq, const bf16_t* Kh, const bf16_t* Vh, bf16_t* Ob, int ldo, int seq,
                                           float negm, const float* qg, float qscale, LAS unsigned char* lds, const int wid, float* rsacc = nullptr, const float* tab = nullptr, int pos0 = 0) {
    constexpr int NDQ = DQK / 16, NDV = DV / 32, NVC = DV / 64, KCPR = DQK / 8, VCPR = DV / 8;
    constexpr int SHM_V = 64 * DV * 2, SHM_K = 64 * 256;
    int lane; asm volatile("v_mbcnt_lo_u32_b32 %0, -1, 0\n\tv_mbcnt_hi_u32_b32 %0, -1, %0" : "=v"(lane));
    const int tid = wid * 64 + lane, r32 = lane & 31, hi = lane >> 5;
    LAS unsigned char* V_lds = lds; LAS unsigned char* K_lds = lds + 3 * SHM_V;
    LAS float* wsf = (LAS float*)(lds + 3 * SHM_V + 3 * SHM_K) + wid * 64;
    bf16x8 qr[NDQ];
    {
        const bf16_t* Qw = Qb + (long)(wid * 32 + r32) * ldq + hi * 8;
        if constexpr (!QNORM) {
#pragma unroll
            for (int d0 = 0; d0 < NDQ; ++d0) qr[d0] = *(const bf16x8*)(Qw + d0 * 16);
        } else {
            u32x4 raw[NDQ]; float ss = 0.f;
#pragma unroll
            for (int d0 = 0; d0 < NDQ; ++d0) { raw[d0] = *(const u32x4*)(Qw + d0 * 16); ss += sumsq8(raw[d0]); }
            ss = swap_add(ss);
            const float rs = qscale / sqrtf(ss * (1.0f / DQK) + EPS);
            float x1[8], x2[8];
#pragma unroll
            for (int d0 = 0; d0 < NDQ; ++d0) { float f[8]; unpack8(raw[d0], f); const float* gp = qg + d0 * 16 + hi * 8;
#pragma unroll
                for (int e = 0; e < 8; ++e) f[e] = f[e] * rs * gp[e];
                if (ROPE && d0 == 4) {
#pragma unroll
                    for (int e = 0; e < 8; ++e) x1[e] = f[e];
                } else if (ROPE && d0 == 5) {
#pragma unroll
                    for (int e = 0; e < 8; ++e) x2[e] = f[e];
                } else qr[d0] = __builtin_bit_cast(bf16x8, pack8(f)); }
            if constexpr (ROPE) {
                const int pos = pos0 + wid * 32 + r32; const float* tt = tab + (hi ? (128 + (pos & 63)) : (pos >> 6)) * 16;
                float o1[8], o2[8];
#pragma unroll
                for (int e = 0; e < 8; ++e) { const float cs = tt[e], sn = tt[8 + e]; o1[e] = x1[e] * cs - x2[e] * sn; o2[e] = x2[e] * cs + x1[e] * sn; }
                qr[4] = __builtin_bit_cast(bf16x8, pack8(o1)); qr[5] = __builtin_bit_cast(bf16x8, pack8(o2));
            }
        }
    }
    constexpr bool K2 = true;
    const int kc0 = tid, kc1 = (64 * KCPR == 1024) ? (tid + 512) : (512 + (tid & 255));
    const int vc1 = tid + 512;
    const int kst0 = KSWZ(kc0 / KCPR, (kc0 % KCPR) * 16), kst1 = KSWZ(kc1 / KCPR, (kc1 % KCPR) * 16);
    const int vst0 = v_st<NDV>(kc0 / VCPR, (kc0 % VCPR) * 8), vst1 = v_st<NDV>(vc1 / VCPR, (vc1 % VCPR) * 8);
    const int vb0 = (int)(unsigned)(size_t)V_lds + v_rd_base(lane);
    bf16x8 sEk0, sEk1, sEv0, sEv1, sOk0, sOk1, sOv0, sOv1;
    if constexpr (NVC != 2) { sEv1 = sOv1 = (bf16x8){0, 0, 0, 0, 0, 0, 0, 0}; }
#define SLOAD(S, kk) do { const bf16_t* kp_ = Kh + (long)(kk) * DQK; const bf16_t* vp_ = Vh + (long)(kk) * DV; \
        S##k0 = *(const bf16x8*)(kp_ + kc0 * 8); if (K2) S##k1 = *(const bf16x8*)(kp_ + kc1 * 8); \
        S##v0 = *(const bf16x8*)(vp_ + kc0 * 8); if constexpr (NVC == 2) S##v1 = *(const bf16x8*)(vp_ + vc1 * 8); } while (0)
#define SWRITE(b, S) do { *(LAS bf16x8*)(K_lds + (b) * SHM_K + kst0) = S##k0; if (K2) *(LAS bf16x8*)(K_lds + (b) * SHM_K + kst1) = S##k1; \
        *(LAS bf16x8*)(V_lds + (b) * SHM_V + vst0) = S##v0; if constexpr (NVC == 2) *(LAS bf16x8*)(V_lds + (b) * SHM_V + vst1) = S##v1; } while (0)
#define QKT(P0, P1, b) do { const LAS unsigned char* ks_ = K_lds + (b) * SHM_K; \
        _Pragma("unroll") for (int r = 0; r < 16; ++r) { P0[r] = negm; P1[r] = negm; } \
        _Pragma("unroll") for (int d0 = 0; d0 < NDQ; ++d0) { const int cb = (d0 * 16 + hi * 8) * 2; \
            const bf16x8 b0_ = *(const LAS bf16x8*)(ks_ + KSWZ(r32, cb)); const bf16x8 b1_ = *(const LAS bf16x8*)(ks_ + KSWZ(32 + r32, cb)); \
            P0 = __builtin_amdgcn_mfma_f32_32x32x16_bf16(b0_, qr[d0], P0, 0, 0, 0); P1 = __builtin_amdgcn_mfma_f32_32x32x16_bf16(b1_, qr[d0], P1, 0, 0, 0); } } while (0)
#define PARTIAL(P0) do { _Pragma("unroll") for (int r = 0; r < 16; ++r) P0[r] = __builtin_amdgcn_exp2f(P0[r]); } while (0)
#define FINISH(P0, P1) do { _Pragma("unroll") for (int r = 0; r < 16; ++r) P1[r] = __builtin_amdgcn_exp2f(P1[r]); \
        float ps_ = 0.f; _Pragma("unroll") for (int r = 0; r < 16; ++r) ps_ += P0[r]; _Pragma("unroll") for (int r = 0; r < 16; ++r) ps_ += P1[r]; \
        l_reg += ps_; pack_p(P0, P1, pa0, pa1, pa2, pa3); } while (0)
    float l_reg = 0.f; f32x16 o[NDV];
#pragma unroll
    for (int d = 0; d < NDV; ++d)
#pragma unroll
        for (int r = 0; r < 16; ++r) o[d][r] = 0.f;
    f32x16 pA0, pA1, pB0, pB1; bf16x8 pa0, pa1, pa2, pa3; const int NT = seq / 64;
#define ATT_BAR() asm volatile("s_waitcnt lgkmcnt(0)\n\ts_barrier" ::: "memory")
    SLOAD(sE, 0); SWRITE(0, sE);
    SLOAD(sO, 64); if (2 < NT) SLOAD(sE, 128);
    ATT_BAR();
    SWRITE(1, sO); if (3 < NT) SLOAD(sO, 192);
    QKT(pA0, pA1, 0); PARTIAL(pA0);
    ATT_BAR();
    int s_prev = 0, s_cur = 1, s_next = 2;
    if (wid >= 4) __builtin_amdgcn_s_setprio(1);
#define ROT3() do { s_prev = s_cur; s_cur = s_next; s_next = (s_next == 2) ? 0 : s_next + 1; } while (0)
    for (int j = 1; j + 1 < NT; j += 2) {
        SWRITE(s_next, sE); if (j + 3 < NT) SLOAD(sE, (j + 3) * 64);
        SBAR(); QKT(pB0, pB1, s_cur);
        FINISH(pA0, pA1); SBAR();
        pv_all<NDV>(o, vb0 + s_prev * SHM_V, pa0, pa1, pa2, pa3); PARTIAL(pB0);
        ATT_BAR(); ROT3();
        if (j + 2 < NT) { SWRITE(s_next, sO); if (j + 4 < NT) SLOAD(sO, (j + 4) * 64); }
        SBAR(); QKT(pA0, pA1, s_cur);
        FINISH(pB0, pB1); SBAR();
        pv_all<NDV>(o, vb0 + s_prev * SHM_V, pa0, pa1, pa2, pa3); PARTIAL(pA0);
        ATT_BAR(); ROT3();
    }
    SBAR(); QKT(pB0, pB1, s_cur);
    FINISH(pA0, pA1); SBAR();
    pv_all<NDV>(o, vb0 + s_prev * SHM_V, pa0, pa1, pa2, pa3); PARTIAL(pB0);
    FINISH(pB0, pB1); SBAR();
    pv_all<NDV>(o, vb0 + s_cur * SHM_V, pa0, pa1, pa2, pa3);
#undef ROT3
#undef ATT_BAR
    __builtin_amdgcn_s_setprio(0);
    l_reg = swap_add(l_reg);
    if (hi == 0) wsf[r32] = l_reg; asm volatile("s_waitcnt lgkmcnt(0)" ::: "memory");
    float rli[16];
#pragma unroll
    for (int r = 0; r < 16; ++r) rli[r] = 1.0f / wsf[crow(r, hi)];
    bf16_t* Ow = Ob + (long)(wid * 32) * ldo;
#pragma unroll
    for (int r = 0; r < 16; ++r) { const int orow = crow(r, hi);
#pragma unroll
        for (int d0 = 0; d0 < NDV; ++d0) { const bf16_t ov = (bf16_t)(pk2(o[d0][r] * rli[r], 0.f) & 0xffffu);
            if constexpr (NDV == 2) ((LAS bf16_t*)(lds + 3 * SHM_V + 3 * SHM_K + 2048) + wid * 2048)[orow * 64 + d0 * 32 + r32] = ov;
            else Ow[(long)orow * ldo + d0 * 32 + r32] = ov; }
        if (rsacc) { float ss = 0.f;
#pragma unroll
            for (int d0 = 0; d0 < NDV; ++d0) { const float v = o[d0][r] * rli[r]; ss += v * v; }
            ss += xorl<1>(ss); ss += xorl<2>(ss); ss += xorl<4>(ss); ss += xorl<8>(ss); ss += xorl<16>(ss);
            if (r32 == 0) __builtin_amdgcn_global_atomic_fadd_f32((__attribute__((address_space(1))) float*)(rsacc + wid * 32 + orow), ss); } }
    if constexpr (NDV == 2) {
        asm volatile("s_waitcnt lgkmcnt(0)" ::: "memory");
        const LAS bf16_t* stg = (const LAS bf16_t*)(lds + 3 * SHM_V + 3 * SHM_K + 2048) + wid * 2048;
#pragma unroll
        for (int i = 0; i < 4; ++i) { const int row = i * 8 + (lane >> 3), ch = lane & 7; const u32x4 v = *(const LAS u32x4*)(stg + row * 64 + ch * 8); *(u32x4*)(Ow + (long)row * ldo + ch * 8) = v; }
    }
    asm volatile("s_waitcnt lgkmcnt(0)\n\ts_barrier" ::: "memory");
#undef SLOAD
#undef SWRITE
#undef QKT
#undef PARTIAL
#undef FINISH
}

__device__ __forceinline__ void na_unit(int b, int r, int h, const bf16_t* Z, bf16_t* OA, float* rsacc, const LAS float* biasT, float negm, LAS unsigned char* wl, LAS float* wsf) {
    const int r0 = min(max(r - 4, 0), 120);
    LAS unsigned char* Kl = wl; LAS unsigned char* Vl = wl + 8192;
#pragma unroll 1
    for (int qb = 0; qb < 2; ++qb) {
        int lane; asm volatile("v_mbcnt_lo_u32_b32 %0, -1, 0\n\tv_mbcnt_hi_u32_b32 %0, -1, %0" : "=v"(lane));
        const int r32 = lane & 31, hi = lane >> 5;
        const int vb = (int)(unsigned)(size_t)Vl + v_rd_base(lane);
        bf16x8 qr[4];
        { const bf16_t* Qp = Z + (long)(b * SEQ + r * 64 + qb * 32 + r32) * ZC + OFF_QNA + h * 64 + hi * 8;
#pragma unroll
          for (int d0 = 0; d0 < 4; ++d0) qr[d0] = *(const bf16x8*)(Qp + d0 * 16); }
        f32x16 o0, o1; float lsum = 0.f;
#pragma unroll
        for (int rr = 0; rr < 16; ++rr) { o0[rr] = 0.f; o1[rr] = 0.f; }
        const int qc = 32 * qb + r32; const int c0 = min(max(qc - 8, 0), 48);
        bf16x8 kst[8], vst[8];
        const bf16_t* srcb0 = Z + ((long)b * SEQ + (long)r0 * 64 + (lane >> 3)) * ZC + h * 64 + (lane & 7) * 8;
#pragma unroll
        for (int i = 0; i < 8; ++i) { kst[i] = *(const bf16x8*)(srcb0 + (long)(8 * i) * ZC + OFF_KNA); vst[i] = *(const bf16x8*)(srcb0 + (long)(8 * i) * ZC + OFF_VNA); }
#pragma unroll 1
        for (int j = 0; j < 8; ++j) {
#pragma unroll
            for (int i = 0; i < 8; ++i) { const int row = (lane >> 3) + 8 * i, cc = lane & 7; *(LAS bf16x8*)(Kl + row * 128 + ((cc * 16) ^ ((row & 7) << 4))) = kst[i]; }
#pragma unroll
            for (int i = 0; i < 8; ++i) { const int row = (lane >> 3) + 8 * i, cc = lane & 7; *(LAS bf16x8*)(Vl + v_st<2>(row, cc * 8)) = vst[i]; }
            asm volatile("" ::: "memory");
            if (j + 1 < 8) { const bf16_t* srcb = srcb0 + (long)(j + 1) * 64 * ZC;
#pragma unroll
                for (int i = 0; i < 8; ++i) { kst[i] = *(const bf16x8*)(srcb + (long)(8 * i) * ZC + OFF_KNA); vst[i] = *(const bf16x8*)(srcb + (long)(8 * i) * ZC + OFF_VNA); } }
            asm volatile("" ::: "memory");
            int brel = 4 * hi - c0, bdc = 4 * hi - qc + 15; asm volatile("" : "+v"(brel), "+v"(bdc));
            const LAS float* brow = biasT + (r0 + j - r + 7) * 32;
            f32x16 p0, p1;
#pragma unroll
            for (int rr = 0; rr < 16; ++rr) { p0[rr] = negm; p1[rr] = negm; }
#pragma unroll
            for (int d0 = 0; d0 < 4; ++d0) { const int cb = ((d0 * 32 + hi * 16) ^ ((r32 & 7) << 4));
                const bf16x8 k0 = *(const LAS bf16x8*)(Kl + r32 * 128 + cb); const bf16x8 k1 = *(const LAS bf16x8*)(Kl + (32 + r32) * 128 + cb);
                p0 = __builtin_amdgcn_mfma_f32_32x32x16_bf16(k0, qr[d0], p0, 0, 0, 0); p1 = __builtin_amdgcn_mfma_f32_32x32x16_bf16(k1, qr[d0], p1, 0, 0, 0); }
            float ps = 0.f;
#define NA_ELEM(P, RR, KOFF) do { const int kk_ = ((RR) & 3) + 8 * ((RR) >> 2) + (KOFF); const int rel_ = brel + kk_; const bool valid_ = (unsigned)rel_ < 16u; const int dc_ = valid_ ? (bdc + kk_) : 0; \
                const float e_ = __builtin_amdgcn_exp2f(P[RR] + brow[dc_]); P[RR] = valid_ ? e_ : 0.f; ps += P[RR]; } while (0)
            if (qb == 0) {
#pragma unroll
                for (int rr = 0; rr < 16; ++rr) NA_ELEM(p0, rr, 0);
#pragma unroll
                for (int rr = 0; rr < 4; ++rr) NA_ELEM(p1, rr, 32);
#pragma unroll
                for (int rr = 4; rr < 16; ++rr) p1[rr] = 0.f;
            } else {
#pragma unroll
                for (int rr = 12; rr < 16; ++rr) NA_ELEM(p0, rr, 0);
#pragma unroll
                for (int rr = 0; rr < 12; ++rr) p0[rr] = 0.f;
#pragma unroll
                for (int rr = 0; rr < 16; ++rr) NA_ELEM(p1, rr, 32);
            }
#undef NA_ELEM
            lsum += ps;
            bf16x8 pa0, pa1, pa2, pa3; pack_p(p0, p1, pa0, pa1, pa2, pa3);
            pv_one<2, 0>(o0, vb, pa0, pa1, pa2, pa3); pv_one<2, 1>(o1, vb, pa0, pa1, pa2, pa3);
            asm volatile("s_waitcnt lgkmcnt(0)" ::: "memory");
        }
        lsum = swap_add(lsum);
        if (hi == 0) wsf[r32] = lsum;
        asm volatile("s_waitcnt lgkmcnt(0)" ::: "memory");
#pragma unroll
        for (int rr = 0; rr < 16; ++rr) { const int orow = crow(rr, hi); const float rl = 1.0f / wsf[orow];
            const long trow = (long)(b * SEQ + r * 64 + qb * 32 + orow);
            bf16_t* op = OA + trow * 1024 + h * 64 + r32;
            const float v0 = o0[rr] * rl, v1 = o1[rr] * rl;
            op[0] = (bf16_t)(pk2(v0, 0.f) & 0xffffu); op[32] = (bf16_t)(pk2(v1, 0.f) & 0xffffu);
            float ss = v0 * v0 + v1 * v1;
            ss += xorl<1>(ss); ss += xorl<2>(ss); ss += xorl<4>(ss); ss += xorl<8>(ss); ss += xorl<16>(ss);
            if (r32 == 0) __builtin_amdgcn_global_atomic_fadd_f32((__attribute__((address_space(1))) float*)(rsacc + trow), ss); }
        asm volatile("s_waitcnt lgkmcnt(0)" ::: "memory");
    }
}
#undef KSWZ
#undef SBAR
}


#define XB_TMO      128
#define XB_XCNT(j)  (256  + 64 * (j))
#define XB_XSUB(j)  (1280 + 64 * (j))
#define XB_XGEN(j)  (2304 + 64 * (j))
#define XB_TOP      3328
#define XB_TOPGEN   3392
#define XCD_BAR_WORDS 3456
#define XB_SPIN_CAP (1u << 18)
__device__ __forceinline__ unsigned xb_ld(unsigned* p)              { return __hip_atomic_load(p, __ATOMIC_RELAXED, __HIP_MEMORY_SCOPE_AGENT); }
__device__ __forceinline__ unsigned xb_add(unsigned* p, unsigned v) { return __hip_atomic_fetch_add(p, v, __ATOMIC_RELAXED, __HIP_MEMORY_SCOPE_AGENT); }
__device__ __forceinline__ unsigned xb_xcc_id() { return (unsigned)__builtin_amdgcn_s_getreg((3 << 11) | 20) & 0xFu; }
#define XB_SPIN(cond, bar) do { unsigned _sp = 0; while (cond) { __builtin_amdgcn_s_sleep(1); \
    if ((++_sp & 255u) == 0u) { if (xb_ld(&(bar)[XB_TMO])) break; if (_sp > XB_SPIN_CAP) { atomicAdd(&(bar)[XB_TMO], 1u); break; } } } } while (0)
struct XcdBarrier { unsigned* bar; unsigned x; volatile LAS unsigned* st; };
__device__ __forceinline__ void xcd_barrier_complete(unsigned* bar, unsigned x, unsigned& nloc, unsigned& nx) {
    const unsigned G = gridDim.x * gridDim.y * gridDim.z;
    unsigned sum, cnt, mine, sp = 0u;
    for (;;) {
        sum = 0u; cnt = 0u; mine = 0u;
#pragma unroll 1
        for (unsigned j = 0; j < 16; ++j) { const unsigned c = xb_ld(&bar[XB_XCNT(j)]); sum += c; cnt += (c > 0u) ? 1u : 0u; mine = (j == x) ? c : mine; }
        if (sum == G) break;
        __builtin_amdgcn_s_sleep(1);
        if ((++sp & 255u) == 0u) { if (xb_ld(&bar[XB_TMO])) break; if (sp > XB_SPIN_CAP) { atomicAdd(&bar[XB_TMO], 1u); break; } }
    }
    nloc = mine > 0u ? mine : 1u; nx = cnt > 0u ? cnt : 1u;
}
__device__ __forceinline__ void xcd_barrier(unsigned* bar, unsigned x, volatile LAS unsigned* st, bool is_t0) {
    asm volatile("s_waitcnt vmcnt(0)" ::: "memory");
    __syncthreads();
    if (is_t0) {
        __builtin_amdgcn_s_waitcnt(0);
        unsigned nloc = st[0], nx = st[1];
        if (nloc == 0u) { xcd_barrier_complete(bar, x, nloc, nx); st[0] = nloc; st[1] = nx; }
        const unsigned old = xb_add(&bar[XB_XSUB(x)], 1u);
        const unsigned gen = old / nloc;
        if (old + 1u == (gen + 1u) * nloc) {
            __builtin_amdgcn_fence(__ATOMIC_RELEASE, "agent");
            asm volatile("s_waitcnt vmcnt(0)" ::: "memory");
            const unsigned og = xb_add(&bar[XB_TOP], 1u);
            const unsigned tg = og / nx;
            if (og + 1u == (tg + 1u) * nx) xb_add(&bar[XB_TOPGEN], 1u);
            else XB_SPIN(xb_ld(&bar[XB_TOPGEN]) == tg, bar);
            __builtin_amdgcn_fence(__ATOMIC_ACQUIRE, "agent");
            xb_add(&bar[XB_XGEN(x)], 1u);
            asm volatile("s_waitcnt vmcnt(0)" ::: "memory");
        } else {
            XB_SPIN(xb_ld(&bar[XB_XGEN(x)]) == gen, bar);
            __builtin_amdgcn_fence(__ATOMIC_ACQUIRE, "agent");
            asm volatile("s_waitcnt vmcnt(0)" ::: "memory");
        }
    }
    __syncthreads();
}

struct Args { const float* in[27]; float* out; unsigned char* ws; int ph_lo, ph_hi; unsigned prog[24]; };
__device__ __forceinline__ int opaque_idx(int i) { asm volatile("" : "+s"(i)); return i; }
__device__ __forceinline__ unsigned opaque_zero() { unsigned z = 0u; asm volatile("" : "+v"(z)); return z; }
enum { I_X = 0, I_MEM, I_MIXG, I_WIN, I_NAQG, I_NAKG, I_RPB, I_QLATG, I_KVLATG, I_WUQ, I_WUKV, I_MLAQG, I_MLAKG, I_GRPG, I_WOUT, I_MEMNG, I_MEMTOKG,
       I_MWQ, I_MWKV, I_MQG, I_MKG, I_MWO, I_FFNG, I_WUP, I_CONVW, I_CONVB, I_WDN };

__device__ __forceinline__ void xpose_item(const float* W, int K, int N, bf16_t* WT, LAS float* scr, int item, int lane, const float* gk = nullptr, int rowmap = 0) {
    const int nblk = N / 32, kb = item / nblk, nb = item % nblk, k0 = 64 * kb, n0 = 32 * nb;
#pragma unroll
    for (int i = 0; i < 32; ++i) { const int kk = 2 * i + (lane >> 5); float w = W[(size_t)(k0 + kk) * N + n0 + (lane & 31)]; if (gk) w *= gk[k0 + kk]; scr[kk * 33 + (lane & 31)] = w; }
    asm volatile("s_waitcnt lgkmcnt(0)" ::: "memory");
    const int c = lane & 7;
    const int r0 = (rowmap == 0) ? n0 : ((n0 < DFF) ? ((n0 >> 7) * 256 + (n0 & 127)) : (((n0 - DFF) >> 7) * 256 + 128 + ((n0 - DFF) & 127)));
#pragma unroll
    for (int j = 0; j < 4; ++j) { const int n = (lane >> 3) + 8 * j; const LAS float* s = scr + (8 * c) * 33 + n;
        u32x4 o; o.x = pk2(s[0 * 33], s[1 * 33]); o.y = pk2(s[2 * 33], s[3 * 33]); o.z = pk2(s[4 * 33], s[5 * 33]); o.w = pk2(s[6 * 33], s[7 * 33]);
        *(u32x4*)(WT + (size_t)(r0 + n) * K + k0 + 8 * c) = o; }
    asm volatile("s_waitcnt lgkmcnt(0)" ::: "memory");
}

__device__ __forceinline__ void norm_row(const float* xrow, const float* g, bf16_t* orow, int lane) {
    const f32x4* xr = (const f32x4*)xrow + lane; const f32x4* gr = (const f32x4*)g + lane;
    f32x4 v[4]; float ss = 0.f;
#pragma unroll
    for (int j = 0; j < 4; ++j) { v[j] = xr[64 * j]; ss += (v[j].x * v[j].x + v[j].y * v[j].y) + (v[j].z * v[j].z + v[j].w * v[j].w); }
    ss = wave_sum(ss);
    const float rstd = 1.0f / sqrtf(ss * (1.0f / 1024.0f) + EPS);
    u32x2* o = (u32x2*)orow + lane;
#pragma unroll
    for (int j = 0; j < 4; ++j) { const f32x4 gg = gr[64 * j]; u32x2 w; w.x = pk2(v[j].x * rstd * gg.x, v[j].y * rstd * gg.y); w.y = pk2(v[j].z * rstd * gg.z, v[j].w * rstd * gg.w); o[64 * j] = w; }
}

__device__ __forceinline__ void sincos_f(float a, float& s, float& c) {
    const float k = rintf(a * 0.636619772367581343f);
    float r = fmaf(-k, 1.57079637050628662109375f, a); r = fmaf(-k, -4.37113900018624283e-8f, r);
    const float r2 = r * r;
    const float sp = r * (1.0f + r2 * (-1.0f / 6 + r2 * (1.0f / 120 + r2 * (-1.0f / 5040 + r2 * (1.0f / 362880 + r2 * (-1.0f / 39916800))))));
    const float cp = 1.0f + r2 * (-0.5f + r2 * (1.0f / 24 + r2 * (-1.0f / 720 + r2 * (1.0f / 40320 + r2 * (-1.0f / 3628800 + r2 * (1.0f / 479001600))))));
    const int q = ((int)k) & 3;
    s = (q == 0) ? sp : (q == 1) ? cp : (q == 2) ? -sp : -cp;
    c = (q == 0) ? cp : (q == 1) ? -sp : (q == 2) ? -cp : sp;
}

#ifndef LBT
#define LBT 512
#endif
__global__ void __launch_bounds__(LBT, 2) mega_fwd(Args args) {
    extern __shared__ __attribute__((aligned(16))) unsigned char lds_raw[];
    LAS unsigned char* lds = (LAS unsigned char*)lds_raw;
    const int G = gridDim.x, bx = blockIdx.x;
    const int wave = __builtin_amdgcn_readfirstlane((int)threadIdx.x >> 6);
    volatile LAS unsigned* bst = (volatile LAS unsigned*)(lds + LDS_MISC);
    if (threadIdx.x == 0) { bst[0] = 0u; bst[1] = 0u; }
    __syncthreads();
    const unsigned xcc = xb_xcc_id();
    float* out = args.out;
    const float* x_in = args.in[opaque_idx(I_X)];
#define TAB ((float*)(ws + WS_TAB))
#define XN ((bf16_t*)(ws + WS_XN))
#define Zb ((bf16_t*)(ws + WS_Z))
#define QM ((bf16_t*)(ws + WS_QM))
#define KVM ((bf16_t*)(ws + WS_KVM))
#define QA ((bf16_t*)(ws + WS_QA))
#define KA ((bf16_t*)(ws + WS_KA))
#define VA ((bf16_t*)(ws + WS_VA))
#define OA ((bf16_t*)(ws + WS_OA))
#define OB ((bf16_t*)(ws + WS_OB))
#define MIX ((bf16_t*)(ws + WS_MIX))
#define QC ((bf16_t*)(ws + WS_QC))
#define OC ((bf16_t*)(ws + WS_OC))
#define Ub ((bf16_t*)(ws + WS_U))
#define ACT ((bf16_t*)(ws + WS_ACT))

    for (int ph = args.ph_lo; ph < args.ph_hi; ++ph) {
        __attribute__((address_space(1))) unsigned char* wsg = (__attribute__((address_space(1))) unsigned char*)args.ws; asm volatile("" : "+s"(wsg));
        unsigned char* ws = (unsigned char*)wsg;
        int lane; asm volatile("v_mbcnt_lo_u32_b32 %0, -1, 0\n\tv_mbcnt_hi_u32_b32 %0, -1, %0" : "=v"(lane));
        const int gw = bx * 8 + wave, NGW = G * 8;
#define TIDX (wave * 64 + lane)
        const int pcode = (int)((args.prog[opaque_idx(ph >> 2)] >> ((ph & 3) * 8)) & 255u);
        if (pcode == 255) {
            LAS float* scr = (LAS float*)(lds + wave * 16384);
            constexpr int IT_IN = 16 * 69, IT_UQ = 6 * 24, IT_UKV = 4 * 32, IT_OUT = 16 * 32, IT_MQ = 16 * 16, IT_MKV = 16 * 32, IT_MO = 8 * 32, IT_UP = 16 * 176, IT_DN = 44 * 32;
            constexpr int IT_L = IT_IN + IT_UQ + IT_UKV + IT_OUT + IT_MQ + IT_MKV + IT_MO + IT_UP + IT_DN;
            for (int it = gw; it < 2 * IT_L; it += NGW) {
                const int l = it / IT_L; int r = it - l * IT_L;
                unsigned char* wb = ws + WS_W + (size_t)l * W_LAYER;
                if (r < IT_IN) { xpose_item(args.in[opaque_idx(I_WIN)] + (size_t)l * 1024 * IN_COLS, 1024, IN_COLS, (bf16_t*)(wb + W_IN), scr, r, lane, args.in[opaque_idx(I_MIXG)] + l * DM); continue; } r -= IT_IN;
                if (r < IT_UQ) { xpose_item(args.in[opaque_idx(I_WUQ)] + (size_t)l * 384 * 768, 384, 768, (bf16_t*)(wb + W_UQ), scr, r, lane); continue; } r -= IT_UQ;
                if (r < IT_UKV) { xpose_item(args.in[opaque_idx(I_WUKV)] + (size_t)l * 256 * 1024, 256, 1024, (bf16_t*)(wb + W_UKV), scr, r, lane); continue; } r -= IT_UKV;
                if (r < IT_OUT) { xpose_item(args.in[opaque_idx(I_WOUT)] + (size_t)l * 1024 * 1024, 1024, 1024, (bf16_t*)(wb + W_OUT), scr, r, lane, args.in[opaque_idx(I_GRPG)] + l * 1024); continue; } r -= IT_OUT;
                if (r < IT_MQ) { xpose_item(args.in[opaque_idx(I_MWQ)] + (size_t)l * 1024 * 512, 1024, 512, (bf16_t*)(wb + W_MQ), scr, r, lane, args.in[opaque_idx(I_MEMNG)] + l * DM); continue; } r -= IT_MQ;
                if (r < IT_MKV) { xpose_item(args.in[opaque_idx(I_MWKV)] + (size_t)l * 1024 * 1024, 1024, 1024, (bf16_t*)(wb + W_MKV), scr, r, lane); continue; } r -= IT_MKV;
                if (r < IT_MO) { xpose_item(args.in[opaque_idx(I_MWO)] + (size_t)l * 512 * 1024, 512, 1024, (bf16_t*)(wb + W_MO), scr, r, lane); continue; } r -= IT_MO;
                if (r < IT_UP) { xpose_item(args.in[opaque_idx(I_WUP)] + (size_t)l * 1024 * DFF2, 1024, DFF2, (bf16_t*)(wb + W_UP), scr, r, lane, args.in[opaque_idx(I_FFNG)] + l * DM, 1); continue; } r -= IT_UP;
                xpose_item(args.in[opaque_idx(I_WDN)] + (size_t)l * DFF * 1024, DFF, 1024, (bf16_t*)(wb + W_DN), scr, r, lane);
            }
            for (int i = bx * 512 + TIDX; i < 2 * 96 * 1024 / 8; i += G * 512) { const int l = i / (96 * 128), rr = i % (96 * 128);
                const unsigned z = opaque_zero();
                *(u32x4*)(ws + WS_W + (size_t)l * W_LAYER + W_IN + (size_t)IN_COLS * 1024 * 2 + (size_t)rr * 16) = (u32x4){z, z, z, z}; }
            if (bx == 0) { for (int i = TIDX; i < (int)(BAR_BYTES / 4); i += 512) ((unsigned*)(ws + WS_BAR))[i] = opaque_zero(); }
            for (int e = bx * 512 + TIDX; e < 192 * 8; e += G * 512) { const int p = e >> 3, j = e & 7; const int pos = p < 128 ? p : p - 128;
                const float inv = ((j & 1) ? 0.31622776601683794f : 1.0f) * ((j >> 1) == 0 ? 1.0f : (j >> 1) == 1 ? 0.1f : (j >> 1) == 2 ? 0.01f : 0.001f);
                float s, c; sincos_f((float)pos * inv, s, c); TAB[p * 16 + j] = c; TAB[p * 16 + 8 + j] = s; }
            {
                f32x4 nx[4];
                { const f32x4* xr = (const f32x4*)(x_in + (size_t)gw * DM) + lane;
#pragma unroll
                  for (int j = 0; j < 4; ++j) nx[j] = xr[64 * j]; }
                for (int m = gw; m < T; m += NGW) {
                    f32x4 v[4];
#pragma unroll
                    for (int j = 0; j < 4; ++j) v[j] = nx[j];
                    if (m + NGW < T) { const f32x4* xr = (const f32x4*)(x_in + (size_t)(m + NGW) * DM) + lane;
#pragma unroll
                        for (int j = 0; j < 4; ++j) nx[j] = xr[64 * j]; }
                    u32x2* o = (u32x2*)(XN + (size_t)m * DM) + lane; float ss = 0.f;
#pragma unroll
                    for (int j = 0; j < 4; ++j) { ss += (v[j].x * v[j].x + v[j].y * v[j].y) + (v[j].z * v[j].z + v[j].w * v[j].w); u32x2 w; w.x = pk2(v[j].x, v[j].y); w.y = pk2(v[j].z, v[j].w); o[64 * j] = w; }
                    ss = wave_sum(ss); if (lane == 0) ((float*)(ws + WS_RS))[m] = ss;
                }
            }
            for (int i = bx * 512 + TIDX; i < 9 * T / 4; i += G * 512) { const unsigned z = opaque_zero(); ((u32x4*)(ws + WS_RS) + T / 4)[i] = (u32x4){z, z, z, z}; }
            for (int m = gw; m < 2 * MEMT; m += NGW) { const int l = m / MEMT, rr = m % MEMT;
                norm_row(args.in[opaque_idx(I_MEM)] + (size_t)rr * DM, args.in[opaque_idx(I_MEMTOKG)] + l * DM, (bf16_t*)(ws + WS_MEMN) + (size_t)m * DM, lane); }
        } else {
            const int l = pcode >> 5, s = pcode & 31;
            unsigned char* wb = ws + WS_W + (size_t)l * W_LAYER;
            const int kind = (s == 1 || s == 3 || s == 7 || s == 9 || s == 11 || s == 13 || s == 15 || s == 17) ? 1 : 0;
            if (kind == 1 && EN_GEMM) {
                const int ng = (s == 1 || s == 3) ? 2 : 1;
#pragma unroll 1
                for (int gi = 0; gi < ng; ++gi) {
                    pg8::Gemm g{nullptr, nullptr, 0, 0, 0, 0, nullptr, nullptr, 256, 0}; pg8::EpiDesc e{0, 0, nullptr, nullptr, nullptr, nullptr, nullptr};
                    float* const RSB = (float*)(ws + WS_RS);
                    switch (s * 2 + gi) {
                    case 2: g = pg8::Gemm{XN, (const bf16_t*)(wb + W_IN), T, ZC, 1024, 1024, nullptr, nullptr, 256, 0}; e = pg8::EpiDesc{0, ZC, Zb, nullptr, RSB + (size_t)(l * 3 + 0) * T, nullptr, nullptr}; break;
                    case 3: g = pg8::Gemm{(const bf16_t*)(ws + WS_MEMN) + (size_t)l * MEMT * DM, (const bf16_t*)(wb + W_MKV), MEMT, 1024, 1024, 1024, nullptr, nullptr, 256, 0};
                            e = pg8::EpiDesc{0, 1024, (bf16_t*)(ws + WS_KVCR) + (size_t)l * MEMT * 1024, nullptr, nullptr, nullptr, nullptr}; break;
                    case 6: g = pg8::Gemm{Zb + OFF_CQ, (const bf16_t*)(wb + W_UQ), T, 768, 384, ZC, nullptr, nullptr, 256, 0}; e = pg8::EpiDesc{0, 768, QM, nullptr, nullptr, nullptr, nullptr}; break;
                    case 7: g = pg8::Gemm{Zb + OFF_CKV, (const bf16_t*)(wb + W_UKV), T, 1024, 256, ZC, nullptr, nullptr, 256, 0}; e = pg8::EpiDesc{0, 1024, KVM, nullptr, nullptr, nullptr, nullptr}; break;
                    case 14: g = pg8::Gemm{MIX, (const bf16_t*)(wb + W_OUT), T, 1024, 1024, 1024, RSB + (size_t)(6 + 2 * l) * T, RSB + (size_t)(7 + 2 * l) * T, 256, 0}; e = pg8::EpiDesc{1, 1024, out, (l == 0) ? x_in : (const float*)out, RSB + (size_t)(l * 3 + 1) * T, XN, RSB + (size_t)(7 + 2 * l) * T}; break;
                    case 18: g = pg8::Gemm{XN, (const bf16_t*)(wb + W_MQ), T, 512, 1024, 1024, nullptr, nullptr, 256, 0}; e = pg8::EpiDesc{0, 512, QC, nullptr, RSB + (size_t)(l * 3 + 1) * T, nullptr, nullptr}; break;
                    case 22: g = pg8::Gemm{OC, (const bf16_t*)(wb + W_MO), T, 1024, 512, 512, nullptr, nullptr, 256, 0}; e = pg8::EpiDesc{1, 1024, out, out, RSB + (size_t)(l * 3 + 2) * T, XN, nullptr}; break;
                    case 26: g = pg8::Gemm{XN - DM, (const bf16_t*)(wb + W_UP), 130 * 256, DFF2, 1024, 1024, nullptr, nullptr, 254, 0};
                             e = pg8::EpiDesc{2, DFF, ACT, args.in[opaque_idx(I_CONVW)] + (size_t)l * 3 * DFF2, RSB + (size_t)(l * 3 + 2) * T, nullptr, args.in[opaque_idx(I_CONVB)] + (size_t)l * DFF2}; break;
                    case 34: g = pg8::Gemm{ACT, (const bf16_t*)(wb + W_DN), T, 1024, DFF, DFF, nullptr, nullptr, 256, 0}; e = pg8::EpiDesc{1, 1024, out, out, RSB + (size_t)(l * 3 + 3) * T, (l == 0) ? XN : nullptr, nullptr}; break;
                    default: break;
                    }
                    LAS pg8::EpiDesc* dl = (LAS pg8::EpiDesc*)(lds + 131072 + 256);
                    __syncthreads();
                    LAS pg8::Gemm* gl = (LAS pg8::Gemm*)(lds + 131072 + 512);
                    if (wave == 0 && lane == 0) { gl->A = g.A; gl->Bt = g.Bt; gl->M = g.M; gl->N = g.N; gl->K = g.K; gl->lda = g.lda; gl->mida = g.mida; gl->midb = g.midb; gl->trows = g.trows; }
                    if (wave == 0 && lane == 0) { dl->mode = e.mode; dl->ldc = e.ldc; dl->dst = e.dst; dl->base = e.base; dl->rs = e.rs; dl->xb = e.xb; dl->rs2 = e.rs2; }
                    __syncthreads();
                    pg8::StaticOrder S; S.init(g.M, g.N, G, (s == 1 && gi == 1) ? ((bx + (G >> 1)) % G) : bx);
                    if (s == 13) { pg8::EpiConv E{dl}; pg8::gemm_phase<pg8::EpiConv, pg8::StaticOrder>(lds, gl, S, E, wave); }
                    else { pg8::EpiUni E{dl}; pg8::gemm_phase<pg8::EpiUni, pg8::StaticOrder>(lds, gl, S, E, wave); }
                }
            } else if (s == 2 && EN_P1) {
                const float* gq = args.in[opaque_idx(I_NAQG)] + l * 64; const float* gk = args.in[opaque_idx(I_NAKG)] + l * 64;
                const float* gcq = args.in[opaque_idx(I_QLATG)] + l * 384; const float* gckv = args.in[opaque_idx(I_KVLATG)] + l * 256;
                const unsigned z0 = opaque_zero();
                u32x4 nq, nk, n4, n5 = (u32x4){z0, z0, z0, z0};
                { const u32x4* zn = (const u32x4*)(Zb + (size_t)gw * ZC); nq = zn[lane]; nk = zn[64 + lane]; n4 = zn[192 + lane]; if (lane < 16) n5 = zn[256 + lane]; }
                for (int row = gw; row < T; row += NGW) {
                    u32x4* z = (u32x4*)(Zb + (size_t)row * ZC);
                    const u32x4 vq = nq, vk = nk, v4 = n4, v5 = n5;
                    if (row + NGW < T) { const u32x4* zn = (const u32x4*)(Zb + (size_t)(row + NGW) * ZC); nq = zn[lane]; nk = zn[64 + lane]; n4 = zn[192 + lane]; if (lane < 16) n5 = zn[256 + lane]; }
                    float fq[8], fk[8], f4[8], f5[8]; unpack8(vq, fq); unpack8(vk, fk); unpack8(v4, f4); unpack8(v5, f5);
                    float sq = 0.f, sk = 0.f, s4 = 0.f, s5 = 0.f;
#pragma unroll
                    for (int e = 0; e < 8; ++e) { sq += fq[e] * fq[e]; sk += fk[e] * fk[e]; s4 += f4[e] * f4[e]; s5 += f5[e] * f5[e]; }
                    sq += xorl<1>(sq); sq += xorl<2>(sq); sq += xorl<4>(sq);
                    sk += xorl<1>(sk); sk += xorl<2>(sk); sk += xorl<4>(sk);
                    const float scq = wave_sum(lane < 48 ? s4 : 0.f);
                    const float sckv = wave_sum((lane >= 48 ? s4 : 0.f) + (lane < 16 ? s5 : 0.f));
                    const float rq = (0.125f * LOG2E) / sqrtf(sq * (1.0f / 64.0f) + EPS), rk = 1.0f / sqrtf(sk * (1.0f / 64.0f) + EPS);
                    const float rcq = 1.0f / sqrtf(scq * (1.0f / 384.0f) + EPS), rckv = 1.0f / sqrtf(sckv * (1.0f / 256.0f) + EPS);
                    const int hc = (lane & 7) * 8;
                    const float* g4 = (lane < 48) ? (gcq + lane * 8) : (gckv + (lane - 48) * 8); const float r4 = (lane < 48) ? rcq : rckv;
                    const float* g5 = gckv + (16 + (lane & 15)) * 8;
#pragma unroll
                    for (int e = 0; e < 8; ++e) { fq[e] *= rq * gq[hc + e]; fk[e] *= rk * gk[hc + e]; f4[e] *= r4 * g4[e]; f5[e] *= rckv * g5[e]; }
                    z[lane] = pack8(fq); z[64 + lane] = pack8(fk); z[192 + lane] = pack8(f4); if (lane < 16) z[256 + lane] = pack8(f5);
                }
                const float* gmk = args.in[opaque_idx(I_MKG)] + l * 128;
                for (int row = gw; row < MEMT; row += NGW) {
                    const u32x4* src = (const u32x4*)((bf16_t*)(ws + WS_KVCR) + ((size_t)l * MEMT + row) * 1024);
                    const u32x4 vk = src[lane], vv = src[64 + lane];
                    float fk[8]; unpack8(vk, fk); float sk = 0.f;
#pragma unroll
                    for (int e = 0; e < 8; ++e) sk += fk[e] * fk[e];
                    sk += xorl<1>(sk); sk += xorl<2>(sk); sk += xorl<4>(sk); sk += xorl<8>(sk);
                    const float rk = 1.0f / sqrtf(sk * (1.0f / 128.0f) + EPS);
                    const int hc = (lane & 15) * 8, hd = lane >> 4, b = row >> 8, m = row & 255;
#pragma unroll
                    for (int e = 0; e < 8; ++e) fk[e] *= rk * gmk[hc + e];
                    const size_t dst = ((size_t)l * MEMT * 512) + (((size_t)(b * 4 + hd) * 256 + m) * 128 + hc);
                    *(u32x4*)((bf16_t*)(ws + WS_KC) + dst) = pack8(fk);
                    *(u32x4*)((bf16_t*)(ws + WS_VC) + dst) = vv;
                }
            } else if (s == 4 && EN_P2) {
                const float* gq = args.in[opaque_idx(I_MLAQG)] + l * 96; const float* gk = args.in[opaque_idx(I_MLAKG)] + l * 96;
                const float qsc = 0.10206207261596575f * LOG2E;
                for (int rep = 0; rep < REP_EW; ++rep)
                for (int idx = bx * 512 + TIDX; idx < T * 8; idx += G * 512) {
                    const int tok = idx >> 3, h = idx & 7, b = tok >> 13, sp = tok & 8191, prow = sp >> 6, pcol = sp & 63;
                    const float* tr = TAB + prow * 16; const float* tc = TAB + (128 + pcol) * 16;
                    const size_t dq = ((size_t)(b * 8 + h) * SEQ + sp) * 96;
                    {
                        const u32x4* srck = (const u32x4*)(KVM + (size_t)tok * 1024 + h * 128);
                        const u32x4* srcr = (const u32x4*)(Zb + (size_t)tok * ZC + OFF_KR);
                        u32x4 c[12]; float ss = 0.f;
#pragma unroll
                        for (int i = 0; i < 8; ++i) { c[i] = srck[i]; ss += sumsq8(c[i]); }
#pragma unroll
                        for (int i = 0; i < 4; ++i) { c[8 + i] = srcr[i]; ss += sumsq8(c[8 + i]); }
                        const float rs = 1.0f / sqrtf(ss * (1.0f / 96.0f) + EPS);
                        u32x4* dst = (u32x4*)(KA + dq);
#pragma unroll
                        for (int i = 0; i < 8; ++i) { float f[8]; unpack8(c[i], f);
#pragma unroll
                            for (int e = 0; e < 8; ++e) f[e] *= rs * gk[i * 8 + e];
                            dst[i] = pack8(f); }
#pragma unroll
                        for (int i = 0; i < 2; ++i) { float x1[8], x2[8], o1[8], o2[8]; unpack8(c[8 + i], x1); unpack8(c[10 + i], x2); const float* tt = i ? tc : tr;
#pragma unroll
                            for (int e = 0; e < 8; ++e) { const float a = x1[e] * rs * gk[64 + i * 8 + e], bb = x2[e] * rs * gk[80 + i * 8 + e]; const float cs = tt[e], sn = tt[8 + e];
                                o1[e] = a * cs - bb * sn; o2[e] = bb * cs + a * sn; }
                            dst[8 + i] = pack8(o1); dst[10 + i] = pack8(o2); }
                        u32x4* dv = (u32x4*)(VA + ((size_t)(b * 8 + h) * SEQ + sp) * 64);
#pragma unroll
                        for (int i = 0; i < 8; ++i) dv[i] = srck[8 + i];
                    }
                }
            } else if (s == 5 && EN_ATT) {
                if (EN_MLA) {
                    const float* gq = args.in[opaque_idx(I_MLAQG)] + l * 96; const float* gk = args.in[opaque_idx(I_MLAKG)] + l * 96;
                    float mq = fmaxf(fabsf(gq[lane]), lane < 32 ? fabsf(gq[64 + lane]) : 0.f), mk = fmaxf(fabsf(gk[lane]), lane < 32 ? fabsf(gk[64 + lane]) : 0.f);
                    mq = wave_max(mq); mk = wave_max(mk);
                    const float negm = -(9.797958971132712f * mq * mk * LOG2E);
                    for (int rep = 0; rep < REP_MLA; ++rep)
                    for (int i = 0;; ++i) {
                        int bh, qb;
                        if (G == 256) { if (i >= 4) break; bh = i * 8 + (bx & 7); qb = bx >> 3; }
                        else { const int u = bx + i * G; if (u >= 1024) break; bh = u >> 5; qb = u & 31; }
                        const int b = bh >> 3, h = bh & 7;
                        att::dense_unit<96, 64, true, true>(QM + ((size_t)b * SEQ + qb * 256) * 768 + h * 96, 768, KA + (size_t)bh * SEQ * 96, VA + (size_t)bh * SEQ * 64,
                                                       MIX + ((size_t)b * SEQ + qb * 256) * 1024 + 512 + h * 64, 1024, SEQ, negm, gq, 0.10206207261596575f * LOG2E, lds, wave, (float*)(ws + WS_RS) + (size_t)(7 + 2 * l) * T + (size_t)b * SEQ + qb * 256, TAB, qb * 256);
                    }
                }
                if (EN_NA) {
                    int lane; asm volatile("v_mbcnt_lo_u32_b32 %0, -1, 0\n\tv_mbcnt_hi_u32_b32 %0, -1, %0" : "=v"(lane));
                    const int h = wave;
                    LAS unsigned char* wl = lds + wave * 16384; LAS float* biasT = (LAS float*)(lds + 131072 + wave * 2048); LAS float* wsf = (LAS float*)(lds + 131072 + 16384 + wave * 256);
                    const float* rp = args.in[opaque_idx(I_RPB)] + ((size_t)l * 8 + h) * 15 * 31;
                    float bm = 0.f;
                    for (int i = lane; i < 15 * 32; i += 64) { const int dr = i >> 5, dc = i & 31; const float v = (dc < 31) ? rp[dr * 31 + dc] : 0.f; biasT[i] = v * LOG2E; bm = fmaxf(bm, fabsf(v)); }
                    bm = wave_max(bm);
                    const float* gq = args.in[opaque_idx(I_NAQG)] + l * 64; const float* gk = args.in[opaque_idx(I_NAKG)] + l * 64;
                    const float mq = wave_max(fabsf(gq[lane])), mk = wave_max(fabsf(gk[lane]));
                    const float negm = -((8.0f * mq * mk + bm) * LOG2E);
                    asm volatile("s_waitcnt lgkmcnt(0)" ::: "memory");
                    for (int rep = 0; rep < REP_NA; ++rep)
                    for (int u = bx; u < BATCH * 128; u += G) att::na_unit(u >> 7, u & 127, h, Zb, MIX, (float*)(ws + WS_RS) + (size_t)(6 + 2 * l) * T, biasT, negm, wl, wsf);
                }
            } else if (s == 10 && EN_CROSS) {
                const float* gq = args.in[opaque_idx(I_MQG)] + l * 128; const float* gk = args.in[opaque_idx(I_MKG)] + l * 128;
                const float mq = wave_max(fmaxf(fabsf(gq[lane]), fabsf(gq[64 + lane]))), mk = wave_max(fmaxf(fabsf(gk[lane]), fabsf(gk[64 + lane])));
                const float negm = -(11.313708498984761f * mq * mk * LOG2E);
                const float qsc = 0.08838834764831845f * LOG2E;
                const bf16_t* KCl = (const bf16_t*)(ws + WS_KC) + (size_t)l * MEMT * 512; const bf16_t* VCl = (const bf16_t*)(ws + WS_VC) + (size_t)l * MEMT * 512;
                for (int rep = 0; rep < REP_CROSS; ++rep)
                for (int u = bx; u < 512; u += G) { const int bhd = u >> 5, qb = u & 31, b = bhd >> 2, hd = bhd & 3;
                    att::dense_unit<128, 128, true>(QC + ((size_t)b * SEQ + qb * 256) * 512 + hd * 128, 512, KCl + (size_t)bhd * 256 * 128, VCl + (size_t)bhd * 256 * 128,
                                                    OC + ((size_t)b * SEQ + qb * 256) * 512 + hd * 128, 512, 256, negm, gq, qsc, lds, wave); }
            } else if ((s == 14 || s == 16) && EN_CONV) {
                const int hf = (s == 16);
                const float* cw = args.in[opaque_idx(I_CONVW)] + (size_t)l * 3 * DFF2; const float* cb = args.in[opaque_idx(I_CONVB)] + (size_t)l * DFF2;
                constexpr int RUN = 8, NCH = DFF / 8, NITEM = (TH / RUN) * NCH;
                for (int it = bx * 512 + TIDX; it < NITEM; it += G * 512) {
                    const int run = it / NCH, nc = it - run * NCH, n0 = nc * 8, t0 = run * RUN;
                    const int s0 = (hf * TH + t0) & (SEQ - 1);
                    const bf16_t* up = Ub + (size_t)t0 * DFF2 + n0;
                    const unsigned z0 = opaque_zero(); const u32x4 zero = (u32x4){z0, z0, z0, z0};
                    u32x4 rg[RUN + 2], rv[RUN + 2];
                    rg[0] = zero; rv[0] = zero; rg[RUN + 1] = zero; rv[RUN + 1] = zero;
                    if (s0 != 0) { rg[0] = *(const u32x4*)(up - DFF2); rv[0] = *(const u32x4*)(up - DFF2 + DFF); }
#pragma unroll
                    for (int i = 0; i < RUN; ++i) { rg[i + 1] = *(const u32x4*)(up + (size_t)i * DFF2); rv[i + 1] = *(const u32x4*)(up + (size_t)i * DFF2 + DFF); }
                    if (s0 + RUN - 1 != SEQ - 1) { rg[RUN + 1] = *(const u32x4*)(up + (size_t)RUN * DFF2); rv[RUN + 1] = *(const u32x4*)(up + (size_t)RUN * DFF2 + DFF); }
                    float w0g[8], w1g[8], w2g[8], bg[8], w0v[8], w1v[8], w2v[8], bv[8];
#pragma unroll
                    for (int e = 0; e < 8; ++e) { w0g[e] = cw[n0 + e]; w1g[e] = cw[DFF2 + n0 + e]; w2g[e] = cw[2 * DFF2 + n0 + e]; bg[e] = cb[n0 + e];
                        w0v[e] = cw[DFF + n0 + e]; w1v[e] = cw[DFF2 + DFF + n0 + e]; w2v[e] = cw[2 * DFF2 + DFF + n0 + e]; bv[e] = cb[DFF + n0 + e]; }
#pragma unroll
                    for (int i = 0; i < RUN; ++i) {
                        float a0[8], a1[8], a2[8], c0[8], c1[8], c2[8], o[8];
                        unpack8(rg[i], a0); unpack8(rg[i + 1], a1); unpack8(rg[i + 2], a2); unpack8(rv[i], c0); unpack8(rv[i + 1], c1); unpack8(rv[i + 2], c2);
#pragma unroll
                        for (int e = 0; e < 8; ++e) { const float gt = a0[e] * w0g[e] + a1[e] * w1g[e] + a2[e] * w2g[e] + bg[e]; const float vl = c0[e] * w0v[e] + c1[e] * w1v[e] + c2[e] * w2v[e] + bv[e];
                            o[e] = gt / (1.0f + __expf(-gt)) * vl; }
                        *(u32x4*)(ACT + (size_t)(t0 + i) * DFF + n0) = pack8(o);
                    }
                }
            }
        }
        if (ph + 1 < args.ph_hi) {
            if (ph == args.ph_lo) { cg::this_grid().sync();
                int ln3; asm volatile("v_mbcnt_lo_u32_b32 %0, -1, 0\n\tv_mbcnt_hi_u32_b32 %0, -1, %0" : "=v"(ln3));
                if (wave == 0 && ln3 == 0) (void)xb_add((unsigned*)(ws + WS_BAR) + XB_XCNT(xcc), 1u); }
            else { int ln2; asm volatile("v_mbcnt_lo_u32_b32 %0, -1, 0\n\tv_mbcnt_hi_u32_b32 %0, -1, %0" : "=v"(ln2));
                   xcd_barrier((unsigned*)(ws + WS_BAR), xcc, bst, wave == 0 && ln2 == 0); }
        }
    }
}

extern "C" void kernel_launch(void* const* d_in, const int* in_sizes, int n_in, void* d_out, int out_size, void* d_ws, size_t ws_size, hipStream_t stream) {
    static int grid = 0;
    if (grid == 0) {
        if (n_in != 27 || in_sizes[0] != T * DM || out_size != T * DM || ws_size < WS_END) { fprintf(stderr, "kernel_launch: unexpected shapes (n_in %d, ws %zu)\n", n_in, ws_size); grid = -1; return; }
        int dev = 0, cus = 0, per_cu = 0;
        hipGetDevice(&dev); hipDeviceGetAttribute(&cus, hipDeviceAttributeMultiprocessorCount, dev);
        if (hipFuncSetAttribute((const void*)mega_fwd, hipFuncAttributeMaxDynamicSharedMemorySize, LDS_BYTES) != hipSuccess) { fprintf(stderr, "kernel_launch: hipFuncSetAttribute failed\n"); grid = -1; return; }
        hipOccupancyMaxActiveBlocksPerMultiprocessor(&per_cu, (const void*)mega_fwd, 512, LDS_BYTES);
        (void)hipGetLastError();
        if (per_cu < 1) per_cu = 1;
        grid = cus * 1;
        if (grid <= 0) grid = 256;
    }
    if (grid < 0) return;
    Args a{};
    for (int i = 0; i < 27; ++i) a.in[i] = (const float*)d_in[i];
    a.out = (float*)d_out; a.ws = (unsigned char*)d_ws;
#ifndef PROBE_MASK
#define PROBE_MASK 0u
#endif
    static const int SEQ15[11] = {1, 2, 3, 4, 5, 7, 9, 10, 11, 13, 17};
    unsigned char pb[96]; int NPH = 0;
    for (int i = 0; i < 96; ++i) pb[i] = 0;
    pb[NPH++] = 255; if (PROBE_MASK & 1u) pb[NPH++] = 255;
    for (int l = 0; l < DEPTH; ++l) for (int i = 0; i < 11; ++i) { const int s = SEQ15[i]; pb[NPH++] = (unsigned char)(l * 32 + s); if ((PROBE_MASK >> s) & 1u) pb[NPH++] = (unsigned char)(l * 32 + s); }
    for (int i = 0; i < 24; ++i) a.prog[i] = (unsigned)pb[4 * i] | ((unsigned)pb[4 * i + 1] << 8) | ((unsigned)pb[4 * i + 2] << 16) | ((unsigned)pb[4 * i + 3] << 24);
#if MK_PER_PHASE
    for (int ph = 0; ph < NPH; ++ph) { a.ph_lo = ph; a.ph_hi = ph + 1; hipLaunchKernelGGL(mega_fwd, dim3(grid), dim3(512), LDS_BYTES, stream, a); }
#else
    a.ph_lo = 0; a.ph_hi = NPH;
    void* kargs[] = {&a};
    hipError_t e = hipLaunchCooperativeKernel((const void*)mega_fwd, dim3(grid), dim3(512), kargs, LDS_BYTES, stream);
    if (e != hipSuccess) fprintf(stderr, "kernel_launch: cooperative launch failed: %s (grid %d)\n", hipGetErrorString(e), grid);
#endif
}
```

```cpp
#include <hip/hip_runtime.h>
#include <hip/hip_cooperative_groups.h>
#include <cstdint>
#include <cstdio>
namespace cg = cooperative_groups;

#ifndef MK_PER_PHASE
#define MK_PER_PHASE 0
#endif


#ifndef EN_GEMM
#define EN_GEMM 1
#endif
#ifndef EN_P1
#define EN_P1 1
#endif
#ifndef EN_P2
#define EN_P2 1
#endif
#ifndef EN_ATT
#define EN_ATT 1
#endif
#ifndef EN_MLA
#define EN_MLA 1
#endif
#ifndef EN_NA
#define EN_NA 1
#endif
#ifndef EN_P3
#define EN_P3 1
#endif
#ifndef EN_CROSS
#define EN_CROSS 1
#endif
#ifndef EN_CONV
#define EN_CONV 1
#endif

#ifndef REP_MLA
#define REP_MLA 1
#endif
#ifndef REP_NA
#define REP_NA 1
#endif
#ifndef REP_CROSS
#define REP_CROSS 1
#endif
#ifndef REP_GEMM0
#define REP_GEMM0 1
#endif
#ifndef REP_EW
#define REP_EW 1
#endif
#ifndef REP_SYNC
#define REP_SYNC 1
#endif
#define LAS __attribute__((address_space(3)))
typedef unsigned short bf16_t;
typedef short bf16x8 __attribute__((ext_vector_type(8)));
typedef short s16x4 __attribute__((ext_vector_type(4)));
typedef float f32x4 __attribute__((ext_vector_type(4)));
typedef float f32x16 __attribute__((ext_vector_type(16)));
typedef unsigned u32x4 __attribute__((ext_vector_type(4)));
typedef unsigned u32x2 __attribute__((ext_vector_type(2)));

constexpr int BATCH = 4, SEQ = 8192, DM = 1024, T = BATCH * SEQ, DEPTH = 2;
constexpr int ZC = 2304;
constexpr int IN_COLS = 2208;
constexpr int OFF_QNA = 0, OFF_KNA = 512, OFF_VNA = 1024, OFF_CQ = 1536, OFF_CKV = 1920, OFF_KR = 2176;
constexpr int DFF = 2816, DFF2 = 5632;
constexpr int MEMT = BATCH * 256;
constexpr float EPS = 1e-6f;
constexpr float LOG2E = 1.4426950408889634f;
constexpr int TH = T / 2;

constexpr size_t MiB = 1u << 20;
constexpr size_t WS_TAB = 0;
constexpr size_t WS_BAR = 512 * 1024, BAR_BYTES = 16384;
constexpr size_t WS_W = 1 * MiB;
constexpr size_t W_IN = 0, W_UQ = W_IN + (size_t)ZC * 1024 * 2, W_UKV = W_UQ + (size_t)768 * 384 * 2, W_OUT = W_UKV + (size_t)1024 * 256 * 2,
                 W_MQ = W_OUT + (size_t)1024 * 1024 * 2, W_MKV = W_MQ + (size_t)512 * 1024 * 2, W_MO = W_MKV + (size_t)1024 * 1024 * 2,
                 W_UP = W_MO + (size_t)1024 * 512 * 2, W_DN = W_UP + (size_t)DFF2 * 1024 * 2, W_LAYER = W_DN + (size_t)1024 * DFF * 2;
static_assert(WS_W + 2 * W_LAYER <= 60 * MiB, "weights");
constexpr size_t WS_MEMN = 60 * MiB, WS_KVCR = 64 * MiB, WS_KC = 68 * MiB, WS_VC = 70 * MiB;
constexpr size_t WS_XN = 72 * MiB;
constexpr size_t WS_QA = 72 * MiB;
constexpr size_t WS_Z = 136 * MiB;
constexpr size_t WS_MIX = 328 * MiB;
constexpr size_t WS_QM = 280 * MiB, WS_KVM = 328 * MiB;
constexpr size_t WS_OA = 280 * MiB, WS_OB = 312 * MiB;
constexpr size_t WS_KA = 392 * MiB, WS_VA = 440 * MiB;
constexpr size_t WS_QC = 136 * MiB, WS_OC = 168 * MiB;
constexpr size_t WS_U = 136 * MiB, WS_ACT = 136 * MiB;
constexpr size_t WS_RS = 472 * MiB;
constexpr size_t WS_END = 474 * MiB;

constexpr int LDS_BYTES = 150 * 1024;
constexpr int LDS_MISC = LDS_BYTES - 64;

__device__ __forceinline__ unsigned pk2(float lo, float hi) { unsigned r; asm("v_cvt_pk_bf16_f32 %0, %1, %2" : "=v"(r) : "v"(lo), "v"(hi)); return r; }
__device__ __forceinline__ float bf_lo(unsigned u) { return __uint_as_float(u << 16); }
__device__ __forceinline__ float bf_hi(unsigned u) { return __uint_as_float(u & 0xffff0000u); }
template <int O> __device__ __forceinline__ float xorl(float v) {
    if constexpr (O < 32) return __uint_as_float((unsigned)__builtin_amdgcn_ds_swizzle((int)__float_as_uint(v), (O << 10) | 0x1f));
    else { auto rr = __builtin_amdgcn_permlane32_swap(__float_as_uint(v), __float_as_uint(v), false, false); return __uint_as_float((__float_as_uint(v) == rr[0]) ? rr[1] : rr[0]); }
}
template <int CTRL> __device__ __forceinline__ float dppf(float old, float srcv) {
    return __int_as_float(__builtin_amdgcn_update_dpp(__float_as_int(old), __float_as_int(srcv), CTRL, 0xf, 0xf, false));
}
template <int CTRL> __device__ __forceinline__ f32x4 rot4(f32x4 s) {
    f32x4 r;
#pragma unroll
    for (int e = 0; e < 4; ++e) r[e] = __int_as_float(__builtin_amdgcn_mov_dpp(__float_as_int(s[e]), CTRL, 0xf, 0xf, false));
    return r;
}
template <int CTRL> __device__ __forceinline__ f32x4 dpp4(f32x4 old, f32x4 s) { f32x4 r; r[0] = dppf<CTRL>(old[0], s[0]); r[1] = dppf<CTRL>(old[1], s[1]); r[2] = dppf<CTRL>(old[2], s[2]); r[3] = dppf<CTRL>(old[3], s[3]); return r; }
__device__ __forceinline__ float att_swap_add(float v) {
    auto rr = __builtin_amdgcn_permlane32_swap(__float_as_uint(v), __float_as_uint(v), false, false);
    return __uint_as_float(rr[0]) + __uint_as_float(rr[1]);
}
__device__ __forceinline__ float wave_sum(float v) {
    v += xorl<1>(v); v += xorl<2>(v); v += xorl<4>(v); v += xorl<8>(v); v += xorl<16>(v);
    auto rr = __builtin_amdgcn_permlane32_swap(__float_as_uint(v), __float_as_uint(v), false, false);
    return __uint_as_float(rr[0]) + __uint_as_float(rr[1]);
}
__device__ __forceinline__ float wave_max(float v) {
    v = fmaxf(v, xorl<1>(v)); v = fmaxf(v, xorl<2>(v)); v = fmaxf(v, xorl<4>(v)); v = fmaxf(v, xorl<8>(v)); v = fmaxf(v, xorl<16>(v));
    auto rr = __builtin_amdgcn_permlane32_swap(__float_as_uint(v), __float_as_uint(v), false, false);
    return fmaxf(__uint_as_float(rr[0]), __uint_as_float(rr[1]));
}
__device__ __forceinline__ void unpack8(const u32x4 v, float* f) {
    f[0] = bf_lo(v.x); f[1] = bf_hi(v.x); f[2] = bf_lo(v.y); f[3] = bf_hi(v.y); f[4] = bf_lo(v.z); f[5] = bf_hi(v.z); f[6] = bf_lo(v.w); f[7] = bf_hi(v.w);
}
__device__ __forceinline__ u32x4 pack8(const float* f) { u32x4 o; o.x = pk2(f[0], f[1]); o.y = pk2(f[2], f[3]); o.z = pk2(f[4], f[5]); o.w = pk2(f[6], f[7]); return o; }
__device__ __forceinline__ float sumsq8(const u32x4 v) { float f[8]; unpack8(v, f); float s = 0.f;
#pragma unroll
    for (int e = 0; e < 8; ++e) s += f[e] * f[e];
    return s; }

namespace pg8 {
constexpr int BM = 256, BK = 64, HALF = 128, HTB = HALF * BK * 2, STAGE_BYTES = 8 * HTB, NXCD = 8, WGM = 8;
__host__ __device__ __forceinline__ int lds_byte(int r, int c) { const int st = (r >> 4) * 2 + (c >> 5), rr = r & 15, cc = c & 31, ob = rr * 64 + cc * 2; return st * 1024 + (ob ^ (((ob >> 9) & 1) << 5)); }
__host__ __device__ __forceinline__ void stage_rc(int b, int& R, int& C) { const int st = b / 1024, sb = b % 1024, swz = sb ^ (((sb >> 9) & 1) << 5); R = (st >> 1) * 16 + swz / 64; C = (st & 1) * 32 + (swz % 64) / 2; }
__host__ __device__ __forceinline__ int perm32(int rho) { const int n = rho >> 4, i = rho & 15; return 8 * (i >> 2) + 4 * n + (i & 3); }

__device__ __forceinline__ const char* uniform_cptr(const char* p) {
    const unsigned long long v = (unsigned long long)p;
    const unsigned lo = __builtin_amdgcn_readfirstlane((unsigned)v), hi = __builtin_amdgcn_readfirstlane((unsigned)(v >> 32));
    return (const char*)(((unsigned long long)hi << 32) | lo);
}
struct Unit { int pm, pn; };
struct Gemm { const bf16_t* A; const bf16_t* Bt; int M, N, K, lda; const float* mida; const float* midb; int trows, pad_; };

struct StaticOrder {
    int nM, nN, nwg, G, c;
    __device__ void init(int M, int N, int G_, int c_) { nM = M / BM; nN = N / BM; nwg = nM * nN; G = G_; c = c_; }
    __device__ bool next(int i, Unit& u) const {
        const long L = (long)i * G + c; if (L >= nwg) return false;
        int wgid = (int)L; { const int q = nwg / NXCD, r = nwg % NXCD, xcd = wgid % NXCD, off = wgid / NXCD; wgid = (xcd < r ? xcd * (q + 1) : r * (q + 1) + (xcd - r) * q) + off; }
        const int nig = WGM * nN, gid = wgid / nig, fm = gid * WGM, gsz = (nM - fm) < WGM ? (nM - fm) : WGM;
        u.pm = fm + ((wgid % nig) % gsz); u.pn = (wgid % nig) / gsz; return true;
    }
};

struct EpiDesc { int mode, ldc; void* dst; const float* base; float* rs; bf16_t* xb; const float* rs2; };
#define GAS __attribute__((address_space(1)))
struct EpiUni {
    static constexpr bool PERM = true, PREFETCH_RS = true;
    const LAS EpiDesc* d;
    __device__ __forceinline__ void operator()(f32x4 (&acc)[2][2][4][2], const Unit& u, int wr, int wc, int fr, int fq, const float (&rsv)[8]) const {
        const int mode = __builtin_amdgcn_readfirstlane(d->mode), ldc = __builtin_amdgcn_readfirstlane(d->ldc);
        GAS float* const rs = (GAS float*)d->rs;
        const int row0 = u.pm * BM + wr * 64 + fr; const int col0 = u.pn * BM + wc * 32 + 8 * fq;
        if (mode == 0) {
            GAS bf16_t* const O = (GAS bf16_t*)d->dst;
            float sc[2][4];
#pragma unroll
            for (int ai = 0; ai < 2; ++ai)
#pragma unroll
                for (int m = 0; m < 4; ++m) sc[ai][m] = rsv[ai * 4 + m];
            if (rs) {
#pragma unroll
                for (int ai = 0; ai < 2; ++ai)
#pragma unroll
                    for (int m = 0; m < 4; ++m) sc[ai][m] = 1.0f / sqrtf(sc[ai][m] * (1.0f / 1024.0f) + EPS);
            } else {
#pragma unroll
                for (int ai = 0; ai < 2; ++ai)
#pragma unroll
                    for (int m = 0; m < 4; ++m) sc[ai][m] = 1.0f;
            }
#pragma unroll
            for (int ai = 0; ai < 2; ++ai)
#pragma unroll
                for (int m = 0; m < 4; ++m) { const int row = row0 + ai * HALF + m * 16; GAS bf16_t* rowp = O + (size_t)row * ldc + col0;
#pragma unroll
                    for (int bj = 0; bj < 2; ++bj) { const f32x4 v0 = acc[ai][bj][m][0] * sc[ai][m], v1 = acc[ai][bj][m][1] * sc[ai][m];
                        u32x4 w; w.x = pk2(v0[0], v0[1]); w.y = pk2(v0[2], v0[3]); w.z = pk2(v1[0], v1[1]); w.w = pk2(v1[2], v1[3]);
                        *(GAS u32x4*)(rowp + bj * HALF) = w; } }
        } else {
            GAS float* const out = (GAS float*)d->dst; const GAS float* const base = (const GAS float*)d->base; GAS bf16_t* const xb = (GAS bf16_t*)d->xb; const GAS float* const rs2 = (const GAS float*)d->rs2;
#pragma unroll
            for (int ab = 0; ab < 4; ++ab) { const int ai = ab >> 1, mb = (ab & 1) * 2;
                f32x4 pre[2][2][2];
#pragma unroll
                for (int mm = 0; mm < 2; ++mm) { const size_t off = (size_t)(row0 + ai * HALF + (mb + mm) * 16) * ldc + col0;
#pragma unroll
                    for (int bj = 0; bj < 2; ++bj) { pre[mm][bj][0] = *(const GAS f32x4*)(base + off + bj * HALF); pre[mm][bj][1] = *(const GAS f32x4*)(base + off + bj * HALF + 4); } }
#pragma unroll
                for (int mm = 0; mm < 2; ++mm) { const int m = mb + mm; const int row = row0 + ai * HALF + m * 16; const size_t off = (size_t)row * ldc + col0; float ss = 0.f;
                    float s2 = 1.0f; if (rs2) s2 = 1.0f / sqrtf(rs2[row] * (1.0f / 512.0f) + EPS);
#pragma unroll
                    for (int bj = 0; bj < 2; ++bj) {
                        const f32x4 o0 = pre[mm][bj][0] + acc[ai][bj][m][0] * s2, o1 = pre[mm][bj][1] + acc[ai][bj][m][1] * s2;
                        *(GAS f32x4*)(out + off + bj * HALF) = o0; *(GAS f32x4*)(out + off + bj * HALF + 4) = o1;
                        if (xb) { u32x4 w; w.x = pk2(o0[0], o0[1]); w.y = pk2(o0[2], o0[3]); w.z = pk2(o1[0], o1[1]); w.w = pk2(o1[2], o1[3]); *(GAS u32x4*)(xb + off + bj * HALF) = w;
                            ss += (o0[0] * o0[0] + o0[1] * o0[1]) + (o0[2] * o0[2] + o0[3] * o0[3]) + (o1[0] * o1[0] + o1[1] * o1[1]) + (o1[2] * o1[2] + o1[3] * o1[3]); } }
                    if (xb) { ss += xorl<16>(ss); ss = att_swap_add(ss); if (fq == 0) __builtin_amdgcn_global_atomic_fadd_f32(rs + row, ss); } }
                asm volatile("" ::: "memory");
            }
        }
    }
};

struct EpiConv {
    static constexpr bool PERM = true, PREFETCH_RS = false;
    const LAS EpiDesc* d;
    __device__ __forceinline__ void operator()(f32x4 (&acc)[2][2][4][2], const Unit& u, int wr, int wc, int fr, int fq, const float (&rsv)[8]) const {
            GAS bf16_t* const ACTp = (GAS bf16_t*)d->dst; const GAS float* const cw = (const GAS float*)d->base; const GAS float* const cbp = (const GAS float*)d->rs2;
            const int tr0 = wr * 64 + fr; const int t0 = u.pm * 254 - 1 + tr0;
#pragma unroll
            for (int ai = 0; ai < 2; ++ai)
#pragma unroll
                for (int m = 0; m < 4; ++m) { const float sc = 1.0f / sqrtf(rsv[ai * 4 + m] * (1.0f / 1024.0f) + EPS);
#pragma unroll
                    for (int bj = 0; bj < 2; ++bj)
#pragma unroll
                        for (int n = 0; n < 2; ++n) acc[ai][bj][m][n] = acc[ai][bj][m][n] * sc; }
            LAS float* const xch = (LAS float*)((LAS unsigned char*)d + 768);
            const int w8 = wr * 4 + wc;
            if (fr == 0) {
#pragma unroll
                for (int ai = 0; ai < 2; ++ai)
#pragma unroll
                    for (int bj = 0; bj < 2; ++bj) { LAS f32x4* p = (LAS f32x4*)(xch + ((((w8 * 2 + ai) * 2 + 0) * 2 + bj) * 4 + fq) * 8); p[0] = acc[ai][bj][0][0]; p[1] = acc[ai][bj][0][1]; }
            }
            if (fr == 15) {
#pragma unroll
                for (int ai = 0; ai < 2; ++ai)
#pragma unroll
                    for (int bj = 0; bj < 2; ++bj) { LAS f32x4* p = (LAS f32x4*)(xch + ((((w8 * 2 + ai) * 2 + 1) * 2 + bj) * 4 + fq) * 8); p[0] = acc[ai][bj][3][0]; p[1] = acc[ai][bj][3][1]; }
            }
            LAS float* const cwl = xch + 2048;
#pragma unroll
            for (int k = 0; k < 2; ++k) { const int idx = w8 * 64 + fq * 16 + fr + 512 * k, bjx = idx >> 9, arr = (idx >> 7) & 3, col = idx & 127;
                const GAS float* sp_ = ((arr < 3) ? (cw + arr * DFF2) : cbp) + bjx * DFF + u.pn * 128 + col; cwl[idx] = *sp_; }
            asm volatile("s_waitcnt vmcnt(0) lgkmcnt(0)" ::: "memory"); __builtin_amdgcn_s_barrier(); asm volatile("" ::: "memory");
            const int colg = u.pn * 128 + wc * 32 + fq * 8; const int cl = wc * 32 + fq * 8;
#pragma unroll
            for (int n = 0; n < 2; ++n) {
                const int c4 = colg + 4 * n;
                const LAS f32x4* const wlg = (const LAS f32x4*)(cwl + cl + 4 * n); const LAS f32x4* const wlv = (const LAS f32x4*)(cwl + 512 + cl + 4 * n);
                const f32x4 w0g = wlg[0], w1g = wlg[32], w2g = wlg[64], bg = wlg[96], w0v = wlv[0], w1v = wlv[32], w2v = wlv[64], bv = wlv[96];
#pragma unroll
                for (int ai = 0; ai < 2; ++ai) {
                    const int pw = (wr == 1) ? wc : ((ai == 1) ? 4 + wc : -1), pai = (wr == 1) ? ai : 0;
                    const int nw = (wr == 0) ? 4 + wc : ((ai == 0) ? wc : -1), nai = (wr == 0) ? ai : 1;
                    f32x4 pHg = (f32x4){0.f, 0.f, 0.f, 0.f}, pHv = pHg, nHg = pHg, nHv = pHg;
                    if (pw >= 0) { pHg = *(const LAS f32x4*)(xch + ((((pw * 2 + pai) * 2 + 1) * 2 + 0) * 4 + fq) * 8 + 4 * n); pHv = *(const LAS f32x4*)(xch + ((((pw * 2 + pai) * 2 + 1) * 2 + 1) * 4 + fq) * 8 + 4 * n); }
                    if (nw >= 0) { nHg = *(const LAS f32x4*)(xch + ((((nw * 2 + nai) * 2 + 0) * 2 + 0) * 4 + fq) * 8 + 4 * n); nHv = *(const LAS f32x4*)(xch + ((((nw * 2 + nai) * 2 + 0) * 2 + 1) * 4 + fq) * 8 + 4 * n); }
#pragma unroll
                    for (int m = 0; m < 4; ++m) {
                        const int t = t0 + ai * HALF + m * 16, rho = tr0 + ai * HALF + m * 16, sp = t & (SEQ - 1);
                        int spl = sp; asm volatile("" : "+v"(spl));
                        const float mp = (spl == 0) ? 0.f : 1.f, mn = (spl == SEQ - 1) ? 0.f : 1.f;
                        float o[4];
                        {
                            const f32x4 cg = acc[ai][0][m][n];
                            const f32x4 fp = (m == 0) ? pHg : rot4<0x121>(acc[ai][0][m == 0 ? 0 : m - 1][n]);
                            const f32x4 fn = (m == 3) ? nHg : rot4<0x12F>(acc[ai][0][m == 3 ? 3 : m + 1][n]);
                            const f32x4 pg = dpp4<0x111>(fp, cg), ng = dpp4<0x101>(fn, cg);
                            const f32x4 gt = (pg * w0g) * mp + cg * w1g + (ng * w2g) * mn + bg;
#pragma unroll
                            for (int e = 0; e < 4; ++e) o[e] = gt[e] * __builtin_amdgcn_rcpf(1.0f + __builtin_amdgcn_exp2f(-1.4426950408889634f * gt[e]));
                        }
                        __builtin_amdgcn_sched_barrier(0);
                        {
                            const f32x4 cv = acc[ai][1][m][n];
                            const f32x4 fp = (m == 0) ? pHv : rot4<0x121>(acc[ai][1][m == 0 ? 0 : m - 1][n]);
                            const f32x4 fn = (m == 3) ? nHv : rot4<0x12F>(acc[ai][1][m == 3 ? 3 : m + 1][n]);
                            const f32x4 pv = dpp4<0x111>(fp, cv), nv = dpp4<0x101>(fn, cv);
                            const f32x4 vl = (pv * w0v) * mp + cv * w1v + (nv * w2v) * mn + bv;
#pragma unroll
                            for (int e = 0; e < 4; ++e) o[e] *= vl[e];
                        }
                        if (rho >= 1 && rho <= 254 && t < T) { u32x2 w; w.x = pk2(o[0], o[1]); w.y = pk2(o[2], o[3]); *(GAS u32x2*)(ACTp + (size_t)t * DFF + c4) = w; }
                        __builtin_amdgcn_sched_barrier(0);
                    }
                }
            }
    }
};

template <class Epi, class Sched>
__device__ __forceinline__ void gemm_phase(LAS unsigned char* lds, const LAS Gemm* gd, const Sched& S, const Epi& E, const int wid) {
    int lane; asm volatile("v_mbcnt_lo_u32_b32 %0, -1, 0\n\tv_mbcnt_hi_u32_b32 %0, -1, %0" : "=v"(lane));
    const int tid = wid * 64 + lane, wr = wid >> 2, wc = wid & 3, fr = lane & 15, fq = lane >> 4;
    const int K = __builtin_amdgcn_readfirstlane(gd->K), nt = K / BK, lda = __builtin_amdgcn_readfirstlane(gd->lda);
#define GD_A (uniform_cptr((const char*)gd->A))
#define GD_B (uniform_cptr((const char*)gd->Bt))
    unsigned voffA[2], voffB[2];
#pragma unroll
    for (int i = 0; i < 2; ++i) { int R, C; stage_rc(tid * 16 + i * 8192, R, C); const int Rb = Epi::PERM ? ((R & ~31) + perm32(R & 31)) : R;
        voffA[i] = (unsigned)(R * lda + C) * 2u; voffB[i] = (unsigned)(Rb * K + C) * 2u; }
    constexpr unsigned kstep = BK * 2;
    const unsigned hstepA = (unsigned)HALF * lda * 2, hstepB = (unsigned)HALF * K * 2;
    const int trows = __builtin_amdgcn_readfirstlane(gd->trows);
    const unsigned tstepA = (unsigned)trows * lda * 2, tstepB = 2 * hstepB;
    const unsigned ldsw = (unsigned)wid * 1024u;
    const int aoff = lds_byte(wr * 64 + fr, fq * 8), boff = lds_byte(wc * 32 + fr, fq * 8);
#define PG8_SA(b, h) (((b) * 2 + (h)) * HTB)
#define PG8_SB(b, h) ((4 + (b) * 2 + (h)) * HTB)
#define PG8_STAGE(bufoff, gbase, voff) do { _Pragma("unroll") for (int _i = 0; _i < 2; ++_i) \
        __builtin_amdgcn_global_load_lds((const unsigned*)((const char*)(gbase) + (voff)[_i]), (LAS unsigned*)(lds + (bufoff) + ldsw + _i * 8192), 16, 0, 0); } while (0)
#define PG8_LDA(dst, b, h) do { _Pragma("unroll") for (int m = 0; m < 4; ++m) _Pragma("unroll") for (int k = 0; k < 2; ++k) dst[m][k] = *(const LAS bf16x8*)(lds + PG8_SA(b, h) + aoff + m * 2048 + k * 1024); } while (0)
#define PG8_LDB(dst, b, h) do { _Pragma("unroll") for (int n = 0; n < 2; ++n) _Pragma("unroll") for (int k = 0; k < 2; ++k) dst[n][k] = *(const LAS bf16x8*)(lds + PG8_SB(b, h) + boff + n * 2048 + k * 1024); } while (0)
#define PG8_MMA(ai, bj, At, Bt) do { __builtin_amdgcn_s_setprio(1); _Pragma("unroll") for (int m = 0; m < 4; ++m) _Pragma("unroll") for (int n = 0; n < 2; ++n) _Pragma("unroll") for (int k = 0; k < 2; ++k) \
        acc[ai][bj][m][n] = __builtin_amdgcn_mfma_f32_16x16x32_bf16(Bt[n][k], At[m][k], acc[ai][bj][m][n], 0, 0, 0); __builtin_amdgcn_s_setprio(0); } while (0)
#define PG8_WAIT_V(n) asm volatile("s_waitcnt vmcnt(" #n ")" ::: "memory")
#define PG8_WAIT_L(n) asm volatile("s_waitcnt lgkmcnt(" #n ")" ::: "memory")
#define PG8_BAR __builtin_amdgcn_s_barrier()
#define PG8_SCHED __builtin_amdgcn_sched_barrier(0)
    Unit cur, nxt; int ui = 0;
    if (!S.next(0, cur)) return;
    const GAS float* const rsp = (E.d->mode != 1) ? (const GAS float*)uniform_cptr((const char*)E.d->rs) : nullptr;
    float rsv[8];
#pragma unroll
    for (int q = 0; q < 8; ++q) rsv[q] = 1024.0f;
    f32x4 acc[2][2][4][2];
#pragma unroll
    for (int a = 0; a < 2; ++a)
#pragma unroll
        for (int b = 0; b < 2; ++b)
#pragma unroll
            for (int m = 0; m < 4; ++m)
#pragma unroll
                for (int n = 0; n < 2; ++n) acc[a][b][m][n] = (f32x4){0.f, 0.f, 0.f, 0.f};
    bf16x8 At[4][2], B0[2][2], B1[2][2];
    const char* cA = GD_A + (unsigned)cur.pm * tstepA; const char* cB = GD_B + (unsigned)cur.pn * tstepB;
    PG8_STAGE(PG8_SB(0, 0), cB, voffB); PG8_STAGE(PG8_SB(0, 1), cB + hstepB, voffB); PG8_STAGE(PG8_SA(0, 0), cA, voffA); PG8_STAGE(PG8_SA(0, 1), cA + hstepA, voffA);
    if (wr == 1) PG8_BAR;
    PG8_WAIT_V(2); PG8_BAR;
    PG8_STAGE(PG8_SB(1, 0), cB + kstep, voffB); PG8_STAGE(PG8_SA(1, 0), cA + kstep, voffA); PG8_STAGE(PG8_SB(1, 1), cB + hstepB + kstep, voffB);
    PG8_WAIT_V(6); PG8_BAR;
    for (;;) {
        const bool has_next = S.next(ui + 1, nxt);
        const char* nA = has_next ? GD_A + (unsigned)nxt.pm * tstepA : cA; const char* nB = has_next ? GD_B + (unsigned)nxt.pn * tstepB : cB;
        for (int t = 0; t < nt; t += 2) {
            if (t == (nt >> 1) && gd->mida != nullptr) {
                const int rbase = cur.pm * BM + wr * 64 + fr;
#pragma unroll
                for (int a = 0; a < 2; ++a)
#pragma unroll
                    for (int m = 0; m < 4; ++m) { const int row = rbase + a * HALF + m * 16;
                        const float qa = ((const GAS float*)uniform_cptr((const char*)gd->mida))[row], qb = ((const GAS float*)uniform_cptr((const char*)gd->midb))[row];
                        const float ratio = sqrtf((qb * (1.0f / 512.0f) + EPS) / (qa * (1.0f / 512.0f) + EPS));
#pragma unroll
                        for (int b = 0; b < 2; ++b)
#pragma unroll
                            for (int n = 0; n < 2; ++n) acc[a][b][m][n] = acc[a][b][m][n] * ratio; }
            }
            const bool last = (t == nt - 2);
            if (Epi::PREFETCH_RS && last && rsp != nullptr) {
                const int rb = cur.pm * trows + (trows == 254 ? -1 : 0) + wr * 64 + fr;
#pragma unroll
                for (int q = 0; q < 8; ++q) rsv[q] = rsp[rb + (q >> 2) * HALF + (q & 3) * 16];
            }
            const char* a1 = cA + (unsigned)(t + 1) * kstep;
            const char* a2 = last ? nA : cA + (unsigned)(t + 2) * kstep; const char* b2 = last ? nB : cB + (unsigned)(t + 2) * kstep;
            const char* a3 = a2 + kstep; const char* b3 = b2 + kstep;
            PG8_LDB(B0, 0, 0); PG8_LDB(B1, 0, 1); PG8_SCHED; PG8_LDA(At, 0, 0); PG8_STAGE(PG8_SA(1, 1), a1 + hstepA, voffA);
            PG8_WAIT_V(8); PG8_WAIT_L(0); PG8_BAR; PG8_MMA(0, 0, At, B0); PG8_MMA(0, 1, At, B1); PG8_BAR; PG8_SCHED;
            PG8_LDA(At, 0, 1); PG8_STAGE(PG8_SB(0, 0), b2, voffB); PG8_STAGE(PG8_SB(0, 1), b2 + hstepB, voffB); PG8_STAGE(PG8_SA(0, 0), a2, voffA);
            PG8_WAIT_V(8); PG8_WAIT_L(0); PG8_BAR; PG8_MMA(1, 0, At, B0); PG8_MMA(1, 1, At, B1); PG8_BAR; PG8_SCHED;
            PG8_LDB(B0, 1, 0); PG8_LDB(B1, 1, 1); PG8_SCHED; PG8_LDA(At, 1, 0); PG8_STAGE(PG8_SA(0, 1), a2 + hstepA, voffA);
            PG8_WAIT_V(8); PG8_WAIT_L(0); PG8_BAR; PG8_MMA(0, 0, At, B0); PG8_MMA(0, 1, At, B1); PG8_BAR; PG8_SCHED;
            PG8_LDA(At, 1, 1); PG8_STAGE(PG8_SB(1, 0), b3, voffB); PG8_STAGE(PG8_SB(1, 1), b3 + hstepB, voffB); PG8_STAGE(PG8_SA(1, 0), a3, voffA);
            PG8_WAIT_V(8); PG8_WAIT_L(0); PG8_BAR; PG8_MMA(1, 0, At, B0); PG8_MMA(1, 1, At, B1); PG8_BAR; PG8_SCHED;
        }
        if (wr == 0) PG8_BAR;
        if constexpr (Epi::PREFETCH_RS) { E(acc, cur, wr, wc, fr, fq, rsv); }
        else { float rl[8]; const int rb = cur.pm * trows + (trows == 254 ? -1 : 0) + wr * 64 + fr;
#pragma unroll
            for (int q = 0; q < 8; ++q) rl[q] = rsp[rb + (q >> 2) * HALF + (q & 3) * 16];
            E(acc, cur, wr, wc, fr, fq, rl); }
        if (!has_next) break;
#pragma unroll
        for (int a = 0; a < 2; ++a)
#pragma unroll
            for (int b = 0; b < 2; ++b)
#pragma unroll
                for (int m = 0; m < 4; ++m)
#pragma unroll
                    for (int n = 0; n < 2; ++n) acc[a][b][m][n] = (f32x4){0.f, 0.f, 0.f, 0.f};
        cur = nxt; cA = nA; cB = nB; ++ui;
        if (wr == 1) PG8_BAR;
    }
    PG8_WAIT_V(0);
    PG8_BAR;
#undef GD_A
#undef GD_B
#undef PG8_SA
#undef PG8_SB
#undef PG8_STAGE
#undef PG8_LDA
#undef PG8_LDB
#undef PG8_MMA
#undef PG8_WAIT_V
#undef PG8_WAIT_L
#undef PG8_BAR
#undef PG8_SCHED
}
}

namespace att {
#define KSWZ(row, colB) ((row) * 256 + ((colB) ^ (((row) & 7) << 4)))
#define SBAR() __builtin_amdgcn_sched_barrier(0)
__device__ __forceinline__ int crow(int r, int hi) { return (r & 3) + 8 * (r >> 2) + 4 * hi; }
template <int NDV> __device__ __forceinline__ int v_st(int k, int c) { const int kk = (k & ~0xC) | ((k & 4) << 1) | ((k & 8) >> 1); return ((kk >> 3) * NDV + (c >> 5)) * 512 + ((kk & 7) * 32 + (c & 31)) * 2; }
__device__ __forceinline__ int v_rd_base(int lane) { return ((lane & 3) << 3) | (((lane >> 2) & 3) << 6) | (((lane >> 4) & 1) << 5) | (((lane >> 5) & 1) << 8); }
template <int OFF> __device__ __forceinline__ s16x4 tr_read(int vb) {
    s16x4 r; asm volatile("ds_read_b64_tr_b16 %0, %1 offset:%2" : "=&v"(r) : "v"(vb), "i"(OFF) : "memory"); return r;
}
template <int NDV, int D0> __device__ __forceinline__ void pv_one(f32x16& od, int vb, bf16x8 pa0, bf16x8 pa1, bf16x8 pa2, bf16x8 pa3) {
    constexpr int KS = 2 * NDV * 512, HF = NDV * 512, B0 = D0 * 512;
    const s16x4 l0 = tr_read<B0>(vb), h0 = tr_read<B0 + HF>(vb), l1 = tr_read<B0 + KS>(vb), h1 = tr_read<B0 + KS + HF>(vb);
    const s16x4 l2 = tr_read<B0 + 2 * KS>(vb), h2 = tr_read<B0 + 2 * KS + HF>(vb), l3 = tr_read<B0 + 3 * KS>(vb), h3 = tr_read<B0 + 3 * KS + HF>(vb);
    asm volatile("s_waitcnt lgkmcnt(0)" ::: "memory"); SBAR();
#define PK(L, H) (bf16x8){L[0], L[1], L[2], L[3], H[0], H[1], H[2], H[3]}
    od = __builtin_amdgcn_mfma_f32_32x32x16_bf16(pa0, PK(l0, h0), od, 0, 0, 0);
    od = __builtin_amdgcn_mfma_f32_32x32x16_bf16(pa1, PK(l1, h1), od, 0, 0, 0);
    od = __builtin_amdgcn_mfma_f32_32x32x16_bf16(pa2, PK(l2, h2), od, 0, 0, 0);
    od = __builtin_amdgcn_mfma_f32_32x32x16_bf16(pa3, PK(l3, h3), od, 0, 0, 0);
#undef PK
}
template <int NDV> __device__ __forceinline__ void pv_all(f32x16* o, int vb, bf16x8 pa0, bf16x8 pa1, bf16x8 pa2, bf16x8 pa3) {
    if constexpr (NDV == 2) {
        constexpr int KS = 2 * NDV * 512, HF = NDV * 512;
        const s16x4 l0 = tr_read<0>(vb), h0 = tr_read<HF>(vb), m0 = tr_read<512>(vb), n0 = tr_read<512 + HF>(vb);
        const s16x4 l1 = tr_read<KS>(vb), h1 = tr_read<KS + HF>(vb), m1 = tr_read<KS + 512>(vb), n1 = tr_read<KS + 512 + HF>(vb);
        const s16x4 l2 = tr_read<2 * KS>(vb), h2 = tr_read<2 * KS + HF>(vb), m2 = tr_read<2 * KS + 512>(vb), n2 = tr_read<2 * KS + 512 + HF>(vb);
        const s16x4 l3 = tr_read<3 * KS>(vb), h3 = tr_read<3 * KS + HF>(vb), m3 = tr_read<3 * KS + 512>(vb), n3 = tr_read<3 * KS + 512 + HF>(vb);
        asm volatile("s_waitcnt lgkmcnt(0)" ::: "memory"); SBAR();
#define PK(L, H) (bf16x8){L[0], L[1], L[2], L[3], H[0], H[1], H[2], H[3]}
        o[0] = __builtin_amdgcn_mfma_f32_32x32x16_bf16(pa0, PK(l0, h0), o[0], 0, 0, 0); o[1] = __builtin_amdgcn_mfma_f32_32x32x16_bf16(pa0, PK(m0, n0), o[1], 0, 0, 0);
        o[0] = __builtin_amdgcn_mfma_f32_32x32x16_bf16(pa1, PK(l1, h1), o[0], 0, 0, 0); o[1] = __builtin_amdgcn_mfma_f32_32x32x16_bf16(pa1, PK(m1, n1), o[1], 0, 0, 0);
        o[0] = __builtin_amdgcn_mfma_f32_32x32x16_bf16(pa2, PK(l2, h2), o[0], 0, 0, 0); o[1] = __builtin_amdgcn_mfma_f32_32x32x16_bf16(pa2, PK(m2, n2), o[1], 0, 0, 0);
        o[0] = __builtin_amdgcn_mfma_f32_32x32x16_bf16(pa3, PK(l3, h3), o[0], 0, 0, 0); o[1] = __builtin_amdgcn_mfma_f32_32x32x16_bf16(pa3, PK(m3, n3), o[1], 0, 0, 0);
#undef PK
    } else {
        pv_one<NDV, 0>(o[0], vb, pa0, pa1, pa2, pa3); pv_one<NDV, 1>(o[1], vb, pa0, pa1, pa2, pa3);
        pv_one<NDV, 2>(o[2], vb, pa0, pa1, pa2, pa3); pv_one<NDV, 3>(o[3], vb, pa0, pa1, pa2, pa3);
    }
}
__device__ __forceinline__ void pack_p(const f32x16& p0, const f32x16& p1, bf16x8& pa0, bf16x8& pa1, bf16x8& pa2, bf16x8& pa3) {
#define PK4(P, BASE, OUT) do { unsigned a0 = pk2(P[BASE + 0], P[BASE + 1]), a1 = pk2(P[BASE + 2], P[BASE + 3]);   \
    unsigned b0 = pk2(P[BASE + 4], P[BASE + 5]), b1 = pk2(P[BASE + 6], P[BASE + 7]);                              \
    auto r0 = __builtin_amdgcn_permlane32_swap(a0, b0, false, false); auto r1 = __builtin_amdgcn_permlane32_swap(a1, b1, false, false); \
    u32x4 w = {r0[0], r1[0], r0[1], r1[1]}; OUT = __builtin_bit_cast(bf16x8, w); } while (0)
    PK4(p0, 0, pa0); PK4(p0, 8, pa1); PK4(p1, 0, pa2); PK4(p1, 8, pa3);
#undef PK4
}
__device__ __forceinline__ float swap_add(float v) {
    auto rr = __builtin_amdgcn_permlane32_swap(__float_as_uint(v), __float_as_uint(v), false, false);
    return __uint_as_float(rr[0]) + __uint_as_float(rr[1]);
}

template <int DQK, int DV, bool QNORM, bool ROPE = false>
__device__ __forceinline__ void dense_unit(const bf16_t* Qb, int ldq, const bf16_t* Kh, const bf16_t* Vh, bf16_t* Ob, int ldo, int seq,
                                           float negm, const float* qg, float qscale, LAS unsigned char* lds, const int wid, float* rsacc = nullptr, const float* tab = nullptr, int pos0 = 0) {
    constexpr int NDQ = DQK / 16, NDV = DV / 32, NVC = DV / 64, KCPR = DQK / 8, VCPR = DV / 8;
    constexpr int SHM_V = 64 * DV * 2, SHM_K = 64 * 256;
    int lane; asm volatile("v_mbcnt_lo_u32_b32 %0, -1, 0\n\tv_mbcnt_hi_u32_b32 %0, -1, %0" : "=v"(lane));
    const int tid = wid * 64 + lane, r32 = lane & 31, hi = lane >> 5;
    LAS unsigned char* V_lds = lds; LAS unsigned char* K_lds = lds + 3 * SHM_V;
    LAS float* wsf = (LAS float*)(lds + 3 * SHM_V + 3 * SHM_K) + wid * 64;
    bf16x8 qr[NDQ];
    {
        const bf16_t* Qw = Qb + (long)(wid * 32 + r32) * ldq + hi * 8;
        if constexpr (!QNORM) {
#pragma unroll
            for (int d0 = 0; d0 < NDQ; ++d0) qr[d0] = *(const bf16x8*)(Qw + d0 * 16);
        } else {
            u32x4 raw[NDQ]; float ss = 0.f;
#pragma unroll
            for (int d0 = 0; d0 < NDQ; ++d0) { raw[d0] = *(const u32x4*)(Qw + d0 * 16); ss += sumsq8(raw[d0]); }
            ss = swap_add(ss);
            const float rs = qscale / sqrtf(ss * (1.0f / DQK) + EPS);
            float x1[8], x2[8];
#pragma unroll
            for (int d0 = 0; d0 < NDQ; ++d0) { float f[8]; unpack8(raw[d0], f); const float* gp = qg + d0 * 16 + hi * 8;
#pragma unroll
                for (int e = 0; e < 8; ++e) f[e] = f[e] * rs * gp[e];
                if (ROPE && d0 == 4) {
#pragma unroll
                    for (int e = 0; e < 8; ++e) x1[e] = f[e];
                } else if (ROPE && d0 == 5) {
#pragma unroll
                    for (int e = 0; e < 8; ++e) x2[e] = f[e];
                } else qr[d0] = __builtin_bit_cast(bf16x8, pack8(f)); }
            if constexpr (ROPE) {
                const int pos = pos0 + wid * 32 + r32; const float* tt = tab + (hi ? (128 + (pos & 63)) : (pos >> 6)) * 16;
                float o1[8], o2[8];
#pragma unroll
                for (int e = 0; e < 8; ++e) { const float cs = tt[e], sn = tt[8 + e]; o1[e] = x1[e] * cs - x2[e] * sn; o2[e] = x2[e] * cs + x1[e] * sn; }
                qr[4] = __builtin_bit_cast(bf16x8, pack8(o1)); qr[5] = __builtin_bit_cast(bf16x8, pack8(o2));
            }
        }
    }
    constexpr bool K2 = true;
    const int kc0 = tid, kc1 = (64 * KCPR == 1024) ? (tid + 512) : (512 + (tid & 255));
    const int vc1 = tid + 512;
    const int kst0 = KSWZ(kc0 / KCPR, (kc0 % KCPR) * 16), kst1 = KSWZ(kc1 / KCPR, (kc1 % KCPR) * 16);
    const int vst0 = v_st<NDV>(kc0 / VCPR, (kc0 % VCPR) * 8), vst1 = v_st<NDV>(vc1 / VCPR, (vc1 % VCPR) * 8);
    const int vb0 = (int)(unsigned)(size_t)V_lds + v_rd_base(lane);
    bf16x8 sEk0, sEk1, sEv0, sEv1, sOk0, sOk1, sOv0, sOv1;
    if constexpr (NVC != 2) { sEv1 = sOv1 = (bf16x8){0, 0, 0, 0, 0, 0, 0, 0}; }
#define SLOAD(S, kk) do { const bf16_t* kp_ = Kh + (long)(kk) * DQK; const bf16_t* vp_ = Vh + (long)(kk) * DV; \
        S##k0 = *(const bf16x8*)(kp_ + kc0 * 8); if (K2) S##k1 = *(const bf16x8*)(kp_ + kc1 * 8); \
        S##v0 = *(const bf16x8*)(vp_ + kc0 * 8); if constexpr (NVC == 2) S##v1 = *(const bf16x8*)(vp_ + vc1 * 8); } while (0)
#define SWRITE(b, S) do { *(LAS bf16x8*)(K_lds + (b) * SHM_K + kst0) = S##k0; if (K2) *(LAS bf16x8*)(K_lds + (b) * SHM_K + kst1) = S##k1; \
        *(LAS bf16x8*)(V_lds + (b) * SHM_V + vst0) = S##v0; if constexpr (NVC == 2) *(LAS bf16x8*)(V_lds + (b) * SHM_V + vst1) = S##v1; } while (0)
#define QKT(P0, P1, b) do { const LAS unsigned char* ks_ = K_lds + (b) * SHM_K; \
        _Pragma("unroll") for (int r = 0; r < 16; ++r) { P0[r] = negm; P1[r] = negm; } \
        _Pragma("unroll") for (int d0 = 0; d0 < NDQ; ++d0) { const int cb = (d0 * 16 + hi * 8) * 2; \
            const bf16x8 b0_ = *(const LAS bf16x8*)(ks_ + KSWZ(r32, cb)); const bf16x8 b1_ = *(const LAS bf16x8*)(ks_ + KSWZ(32 + r32, cb)); \
            P0 = __builtin_amdgcn_mfma_f32_32x32x16_bf16(b0_, qr[d0], P0, 0, 0, 0); P1 = __builtin_amdgcn_mfma_f32_32x32x16_bf16(b1_, qr[d0], P1, 0, 0, 0); } } while (0)
#define PARTIAL(P0) do { _Pragma("unroll") for (int r = 0; r < 16; ++r) P0[r] = __builtin_amdgcn_exp2f(P0[r]); } while (0)
#define FINISH(P0, P1) do { _Pragma("unroll") for (int r = 0; r < 16; ++r) P1[r] = __builtin_amdgcn_exp2f(P1[r]); \
        float ps_ = 0.f; _Pragma("unroll") for (int r = 0; r < 16; ++r) ps_ += P0[r]; _Pragma("unroll") for (int r = 0; r < 16; ++r) ps_ += P1[r]; \
        l_reg += ps_; pack_p(P0, P1, pa0, pa1, pa2, pa3); } while (0)
    float l_reg = 0.f; f32x16 o[NDV];
#pragma unroll
    for (int d = 0; d < NDV; ++d)
#pragma unroll
        for (int r = 0; r < 16; ++r) o[d][r] = 0.f;
    f32x16 pA0, pA1, pB0, pB1; bf16x8 pa0, pa1, pa2, pa3; const int NT = seq / 64;
#define ATT_BAR() asm volatile("s_waitcnt lgkmcnt(0)\n\ts_barrier" ::: "memory")
    SLOAD(sE, 0); SWRITE(0, sE);
    SLOAD(sO, 64); if (2 < NT) SLOAD(sE, 128);
    ATT_BAR();
    SWRITE(1, sO); if (3 < NT) SLOAD(sO, 192);
    QKT(pA0, pA1, 0); PARTIAL(pA0);
    ATT_BAR();
    int s_prev = 0, s_cur = 1, s_next = 2;
    if (wid >= 4) __builtin_amdgcn_s_setprio(1);
#define ROT3() do { s_prev = s_cur; s_cur = s_next; s_next = (s_next == 2) ? 0 : s_next + 1; } while (0)
    for (int j = 1; j + 1 < NT; j += 2) {
        SWRITE(s_next, sE); if (j + 3 < NT) SLOAD(sE, (j + 3) * 64);
        SBAR(); QKT(pB0, pB1, s_cur);
        FINISH(pA0, pA1); SBAR();
        pv_all<NDV>(o, vb0 + s_prev * SHM_V, pa0, pa1, pa2, pa3); PARTIAL(pB0);
        ATT_BAR(); ROT3();
        if (j + 2 < NT) { SWRITE(s_next, sO); if (j + 4 < NT) SLOAD(sO, (j + 4) * 64); }
        SBAR(); QKT(pA0, pA1, s_cur);
        FINISH(pB0, pB1); SBAR();
        pv_all<NDV>(o, vb0 + s_prev * SHM_V, pa0, pa1, pa2, pa3); PARTIAL(pA0);
        ATT_BAR(); ROT3();
    }
    SBAR(); QKT(pB0, pB1, s_cur);
    FINISH(pA0, pA1); SBAR();
    pv_all<NDV>(o, vb0 + s_prev * SHM_V, pa0, pa1, pa2, pa3); PARTIAL(pB0);
    FINISH(pB0, pB1); SBAR();
    pv_all<NDV>(o, vb0 + s_cur * SHM_V, pa0, pa1, pa2, pa3);
#undef ROT3
#undef ATT_BAR
    __builtin_amdgcn_s_setprio(0);
    l_reg = swap_add(l_reg);
    if (hi == 0) wsf[r32] = l_reg; asm volatile("s_waitcnt lgkmcnt(0)" ::: "memory");
    float rli[16];
#pragma unroll
    for (int r = 0; r < 16; ++r) rli[r] = 1.0f / wsf[crow(r, hi)];
    bf16_t* Ow = Ob + (long)(wid * 32) * ldo;
#pragma unroll
    for (int r = 0; r < 16; ++r) { const int orow = crow(r, hi);
#pragma unroll
        for (int d0 = 0; d0 < NDV; ++d0) { const bf16_t ov = (bf16_t)(pk2(o[d0][r] * rli[r], 0.f) & 0xffffu);
            if constexpr (NDV == 2) ((LAS bf16_t*)(lds + 3 * SHM_V + 3 * SHM_K + 2048) + wid * 2048)[orow * 64 + d0 * 32 + r32] = ov;
            else Ow[(long)orow * ldo + d0 * 32 + r32] = ov; }
        if (rsacc) { float ss = 0.f;
#pragma unroll
            for (int d0 = 0; d0 < NDV; ++d0) { const float v = o[d0][r] * rli[r]; ss += v * v; }
            ss += xorl<1>(ss); ss += xorl<2>(ss); ss += xorl<4>(ss); ss += xorl<8>(ss); ss += xorl<16>(ss);
            if (r32 == 0) __builtin_amdgcn_global_atomic_fadd_f32((__attribute__((address_space(1))) float*)(rsacc + wid * 32 + orow), ss); } }
    if constexpr (NDV == 2) {
        asm volatile("s_waitcnt lgkmcnt(0)" ::: "memory");
        const LAS bf16_t* stg = (const LAS bf16_t*)(lds + 3 * SHM_V + 3 * SHM_K + 2048) + wid * 2048;
#pragma unroll
        for (int i = 0; i < 4; ++i) { const int row = i * 8 + (lane >> 3), ch = lane & 7; const u32x4 v = *(const LAS u32x4*)(stg + row * 64 + ch * 8); *(u32x4*)(Ow + (long)row * ldo + ch * 8) = v; }
    }
    asm volatile("s_waitcnt lgkmcnt(0)\n\ts_barrier" ::: "memory");
#undef SLOAD
#undef SWRITE
#undef QKT
#undef PARTIAL
#undef FINISH
}

__device__ __forceinline__ void na_unit(int b, int r, int h, const bf16_t* Z, bf16_t* OA, float* rsacc, const LAS float* biasT, float negm, LAS unsigned char* wl, LAS float* wsf) {
    const int r0 = min(max(r - 4, 0), 120);
    LAS unsigned char* Kl = wl; LAS unsigned char* Vl = wl + 8192;
#pragma unroll 1
    for (int qb = 0; qb < 2; ++qb) {
        int lane; asm volatile("v_mbcnt_lo_u32_b32 %0, -1, 0\n\tv_mbcnt_hi_u32_b32 %0, -1, %0" : "=v"(lane));
        const int r32 = lane & 31, hi = lane >> 5;
        const int vb = (int)(unsigned)(size_t)Vl + v_rd_base(lane);
        bf16x8 qr[4];
        { const bf16_t* Qp = Z + (long)(b * SEQ + r * 64 + qb * 32 + r32) * ZC + OFF_QNA + h * 64 + hi * 8;
#pragma unroll
          for (int d0 = 0; d0 < 4; ++d0) qr[d0] = *(const bf16x8*)(Qp + d0 * 16); }
        f32x16 o0, o1; float lsum = 0.f;
#pragma unroll
        for (int rr = 0; rr < 16; ++rr) { o0[rr] = 0.f; o1[rr] = 0.f; }
        const int qc = 32 * qb + r32; const int c0 = min(max(qc - 8, 0), 48);
        bf16x8 kst[8], vst[8];
        const bf16_t* srcb0 = Z + ((long)b * SEQ + (long)r0 * 64 + (lane >> 3)) * ZC + h * 64 + (lane & 7) * 8;
#pragma unroll
        for (int i = 0; i < 8; ++i) { kst[i] = *(const bf16x8*)(srcb0 + (long)(8 * i) * ZC + OFF_KNA); vst[i] = *(const bf16x8*)(srcb0 + (long)(8 * i) * ZC + OFF_VNA); }
#pragma unroll 1
        for (int j = 0; j < 8; ++j) {
#pragma unroll
            for (int i = 0; i < 8; ++i) { const int row = (lane >> 3) + 8 * i, cc = lane & 7; *(LAS bf16x8*)(Kl + row * 128 + ((cc * 16) ^ ((row & 7) << 4))) = kst[i]; }
#pragma unroll
            for (int i = 0; i < 8; ++i) { const int row = (lane >> 3) + 8 * i, cc = lane & 7; *(LAS bf16x8*)(Vl + v_st<2>(row, cc * 8)) = vst[i]; }
            asm volatile("" ::: "memory");
            if (j + 1 < 8) { const bf16_t* srcb = srcb0 + (long)(j + 1) * 64 * ZC;
#pragma unroll
                for (int i = 0; i < 8; ++i) { kst[i] = *(const bf16x8*)(srcb + (long)(8 * i) * ZC + OFF_KNA); vst[i] = *(const bf16x8*)(srcb + (long)(8 * i) * ZC + OFF_VNA); } }
            asm volatile("" ::: "memory");
            int brel = 4 * hi - c0, bdc = 4 * hi - qc + 15; asm volatile("" : "+v"(brel), "+v"(bdc));
            const LAS float* brow = biasT + (r0 + j - r + 7) * 32;
            f32x16 p0, p1;
#pragma unroll
            for (int rr = 0; rr < 16; ++rr) { p0[rr] = negm; p1[rr] = negm; }
#pragma unroll
            for (int d0 = 0; d0 < 4; ++d0) { const int cb = ((d0 * 32 + hi * 16) ^ ((r32 & 7) << 4));
                const bf16x8 k0 = *(const LAS bf16x8*)(Kl + r32 * 128 + cb); const bf16x8 k1 = *(const LAS bf16x8*)(Kl + (32 + r32) * 128 + cb);
                p0 = __builtin_amdgcn_mfma_f32_32x32x16_bf16(k0, qr[d0], p0, 0, 0, 0); p1 = __builtin_amdgcn_mfma_f32_32x32x16_bf16(k1, qr[d0], p1, 0, 0, 0); }
            float ps = 0.f;
#define NA_ELEM(P, RR, KOFF) do { const int kk_ = ((RR) & 3) + 8 * ((RR) >> 2) + (KOFF); const int rel_ = brel + kk_; const bool valid_ = (unsigned)rel_ < 16u; const int dc_ = valid_ ? (bdc + kk_) : 0; \
                const float e_ = __builtin_amdgcn_exp2f(P[RR] + brow[dc_]); P[RR] = valid_ ? e_ : 0.f; ps += P[RR]; } while (0)
            if (qb == 0) {
#pragma unroll
                for (int rr = 0; rr < 16; ++rr) NA_ELEM(p0, rr, 0);
#pragma unroll
                for (int rr = 0; rr < 4; ++rr) NA_ELEM(p1, rr, 32);
#pragma unroll
                for (int rr = 4; rr < 16; ++rr) p1[rr] = 0.f;
            } else {
#pragma unroll
                for (int rr = 12; rr < 16; ++rr) NA_ELEM(p0, rr, 0);
#pragma unroll
                for (int rr = 0; rr < 12; ++rr) p0[rr] = 0.f;
#pragma unroll
                for (int rr = 0; rr < 16; ++rr) NA_ELEM(p1, rr, 32);
            }
#undef NA_ELEM
            lsum += ps;
            bf16x8 pa0, pa1, pa2, pa3; pack_p(p0, p1, pa0, pa1, pa2, pa3);
            pv_one<2, 0>(o0, vb, pa0, pa1, pa2, pa3); pv_one<2, 1>(o1, vb, pa0, pa1, pa2, pa3);
            asm volatile("s_waitcnt lgkmcnt(0)" ::: "memory");
        }
        lsum = swap_add(lsum);
        if (hi == 0) wsf[r32] = lsum;
        asm volatile("s_waitcnt lgkmcnt(0)" ::: "memory");
#pragma unroll
        for (int rr = 0; rr < 16; ++rr) { const int orow = crow(rr, hi); const float rl = 1.0f / wsf[orow];
            const long trow = (long)(b * SEQ + r * 64 + qb * 32 + orow);
            bf16_t* op = OA + trow * 1024 + h * 64 + r32;
            const float v0 = o0[rr] * rl, v1 = o1[rr] * rl;
            ((LAS bf16_t*)Kl)[orow * 64 + r32] = (bf16_t)(pk2(v0, 0.f) & 0xffffu); ((LAS bf16_t*)Kl)[orow * 64 + 32 + r32] = (bf16_t)(pk2(v1, 0.f) & 0xffffu);
            float ss = v0 * v0 + v1 * v1;
            ss += xorl<1>(ss); ss += xorl<2>(ss); ss += xorl<4>(ss); ss += xorl<8>(ss); ss += xorl<16>(ss);
            if (r32 == 0) __builtin_amdgcn_global_atomic_fadd_f32((__attribute__((address_space(1))) float*)(rsacc + trow), ss); }
        asm volatile("s_waitcnt lgkmcnt(0)" ::: "memory");
#pragma unroll
        for (int i = 0; i < 4; ++i) { const int row = i * 8 + (lane >> 3), ch = lane & 7; const u32x4 v = *(const LAS u32x4*)((const LAS bf16_t*)Kl + row * 64 + ch * 8);
            *(u32x4*)(OA + (long)(b * SEQ + r * 64 + qb * 32 + row) * 1024 + h * 64 + ch * 8) = v; }
        asm volatile("s_waitcnt lgkmcnt(0)" ::: "memory");
    }
}
#undef KSWZ
#undef SBAR
}


#define XB_TMO      128
#define XB_XCNT(j)  (256  + 64 * (j))
#define XB_XSUB(j)  (1280 + 64 * (j))
#define XB_XGEN(j)  (2304 + 64 * (j))
#define XB_TOP      3328
#define XB_TOPGEN   3392
#define XCD_BAR_WORDS 3456
#define XB_SPIN_CAP (1u << 18)
__device__ __forceinline__ unsigned xb_ld(unsigned* p)              { return __hip_atomic_load(p, __ATOMIC_RELAXED, __HIP_MEMORY_SCOPE_AGENT); }
__device__ __forceinline__ unsigned xb_add(unsigned* p, unsigned v) { return __hip_atomic_fetch_add(p, v, __ATOMIC_RELAXED, __HIP_MEMORY_SCOPE_AGENT); }
__device__ __forceinline__ unsigned xb_xcc_id() { return (unsigned)__builtin_amdgcn_s_getreg((3 << 11) | 20) & 0xFu; }
#define XB_SPIN(cond, bar) do { unsigned _sp = 0; while (cond) { __builtin_amdgcn_s_sleep(1); \
    if ((++_sp & 255u) == 0u) { if (xb_ld(&(bar)[XB_TMO])) break; if (_sp > XB_SPIN_CAP) { atomicAdd(&(bar)[XB_TMO], 1u); break; } } } } while (0)
struct XcdBarrier { unsigned* bar; unsigned x; volatile LAS unsigned* st; };
__device__ __forceinline__ void xcd_barrier_complete(unsigned* bar, unsigned x, unsigned& nloc, unsigned& nx) {
    const unsigned G = gridDim.x * gridDim.y * gridDim.z;
    unsigned sum, cnt, mine, sp = 0u;
    for (;;) {
        sum = 0u; cnt = 0u; mine = 0u;
#pragma unroll 1
        for (unsigned j = 0; j < 16; ++j) { const unsigned c = xb_ld(&bar[XB_XCNT(j)]); sum += c; cnt += (c > 0u) ? 1u : 0u; mine = (j == x) ? c : mine; }
        if (sum == G) break;
        __builtin_amdgcn_s_sleep(1);
        if ((++sp & 255u) == 0u) { if (xb_ld(&bar[XB_TMO])) break; if (sp > XB_SPIN_CAP) { atomicAdd(&bar[XB_TMO], 1u); break; } }
    }
    nloc = mine > 0u ? mine : 1u; nx = cnt > 0u ? cnt : 1u;
}
__device__ __forceinline__ void xcd_barrier(unsigned* bar, unsigned x, volatile LAS unsigned* st, bool is_t0) {
    asm volatile("s_waitcnt vmcnt(0)" ::: "memory");
    __syncthreads();
    if (is_t0) {
        __builtin_amdgcn_s_waitcnt(0);
        unsigned nloc = st[0], nx = st[1];
        if (nloc == 0u) { xcd_barrier_complete(bar, x, nloc, nx); st[0] = nloc; st[1] = nx; }
        const unsigned old = xb_add(&bar[XB_XSUB(x)], 1u);
        const unsigned gen = old / nloc;
        if (old + 1u == (gen + 1u) * nloc) {
            __builtin_amdgcn_fence(__ATOMIC_RELEASE, "agent");
            asm volatile("s_waitcnt vmcnt(0)" ::: "memory");
            const unsigned og = xb_add(&bar[XB_TOP], 1u);
            const unsigned tg = og / nx;
            if (og + 1u == (tg + 1u) * nx) xb_add(&bar[XB_TOPGEN], 1u);
            else XB_SPIN(xb_ld(&bar[XB_TOPGEN]) == tg, bar);
            __builtin_amdgcn_fence(__ATOMIC_ACQUIRE, "agent");
            xb_add(&bar[XB_XGEN(x)], 1u);
            asm volatile("s_waitcnt vmcnt(0)" ::: "memory");
        } else {
            XB_SPIN(xb_ld(&bar[XB_XGEN(x)]) == gen, bar);
            __builtin_amdgcn_fence(__ATOMIC_ACQUIRE, "agent");
            asm volatile("s_waitcnt vmcnt(0)" ::: "memory");
        }
    }
    __syncthreads();
}

struct Args { const float* in[27]; float* out; unsigned char* ws; int ph_lo, ph_hi; unsigned prog[24]; };
__device__ __forceinline__ int opaque_idx(int i) { asm volatile("" : "+s"(i)); return i; }
__device__ __forceinline__ unsigned opaque_zero() { unsigned z = 0u; asm volatile("" : "+v"(z)); return z; }
enum { I_X = 0, I_MEM, I_MIXG, I_WIN, I_NAQG, I_NAKG, I_RPB, I_QLATG, I_KVLATG, I_WUQ, I_WUKV, I_MLAQG, I_MLAKG, I_GRPG, I_WOUT, I_MEMNG, I_MEMTOKG,
       I_MWQ, I_MWKV, I_MQG, I_MKG, I_MWO, I_FFNG, I_WUP, I_CONVW, I_CONVB, I_WDN };

__device__ __forceinline__ void xpose_item(const float* W, int K, int N, bf16_t* WT, LAS float* scr, int item, int lane, const float* gk = nullptr, int rowmap = 0) {
    const int nblk = N / 32, kb = item / nblk, nb = item % nblk, k0 = 64 * kb, n0 = 32 * nb;
#pragma unroll
    for (int i = 0; i < 32; ++i) { const int kk = 2 * i + (lane >> 5); float w = W[(size_t)(k0 + kk) * N + n0 + (lane & 31)]; if (gk) w *= gk[k0 + kk]; scr[kk * 33 + (lane & 31)] = w; }
    asm volatile("s_waitcnt lgkmcnt(0)" ::: "memory");
    const int c = lane & 7;
    const int r0 = (rowmap == 0) ? n0 : ((n0 < DFF) ? ((n0 >> 7) * 256 + (n0 & 127)) : (((n0 - DFF) >> 7) * 256 + 128 + ((n0 - DFF) & 127)));
#pragma unroll
    for (int j = 0; j < 4; ++j) { const int n = (lane >> 3) + 8 * j; const LAS float* s = scr + (8 * c) * 33 + n;
        u32x4 o; o.x = pk2(s[0 * 33], s[1 * 33]); o.y = pk2(s[2 * 33], s[3 * 33]); o.z = pk2(s[4 * 33], s[5 * 33]); o.w = pk2(s[6 * 33], s[7 * 33]);
        *(u32x4*)(WT + (size_t)(r0 + n) * K + k0 + 8 * c) = o; }
    asm volatile("s_waitcnt lgkmcnt(0)" ::: "memory");
}

__device__ __forceinline__ void norm_row(const float* xrow, const float* g, bf16_t* orow, int lane) {
    const f32x4* xr = (const f32x4*)xrow + lane; const f32x4* gr = (const f32x4*)g + lane;
    f32x4 v[4]; float ss = 0.f;
#pragma unroll
    for (int j = 0; j < 4; ++j) { v[j] = xr[64 * j]; ss += (v[j].x * v[j].x + v[j].y * v[j].y) + (v[j].z * v[j].z + v[j].w * v[j].w); }
    ss = wave_sum(ss);
    const float rstd = 1.0f / sqrtf(ss * (1.0f / 1024.0f) + EPS);
    u32x2* o = (u32x2*)orow + lane;
#pragma unroll
    for (int j = 0; j < 4; ++j) { const f32x4 gg = gr[64 * j]; u32x2 w; w.x = pk2(v[j].x * rstd * gg.x, v[j].y * rstd * gg.y); w.y = pk2(v[j].z * rstd * gg.z, v[j].w * rstd * gg.w); o[64 * j] = w; }
}

__device__ __forceinline__ void sincos_f(float a, float& s, float& c) {
    const float k = rintf(a * 0.636619772367581343f);
    float r = fmaf(-k, 1.57079637050628662109375f, a); r = fmaf(-k, -4.37113900018624283e-8f, r);
    const float r2 = r * r;
    const float sp = r * (1.0f + r2 * (-1.0f / 6 + r2 * (1.0f / 120 + r2 * (-1.0f / 5040 + r2 * (1.0f / 362880 + r2 * (-1.0f / 39916800))))));
    const float cp = 1.0f + r2 * (-0.5f + r2 * (1.0f / 24 + r2 * (-1.0f / 720 + r2 * (1.0f / 40320 + r2 * (-1.0f / 3628800 + r2 * (1.0f / 479001600))))));
    const int q = ((int)k) & 3;
    s = (q == 0) ? sp : (q == 1) ? cp : (q == 2) ? -sp : -cp;
    c = (q == 0) ? cp : (q == 1) ? -sp : (q == 2) ? -cp : sp;
}

#ifndef LBT
#define LBT 512
#endif
__global__ void __launch_bounds__(LBT, 2) mega_fwd(Args args) {
    extern __shared__ __attribute__((aligned(16))) unsigned char lds_raw[];
    LAS unsigned char* lds = (LAS unsigned char*)lds_raw;
    const int G = gridDim.x, bx = blockIdx.x;
    const int wave = __builtin_amdgcn_readfirstlane((int)threadIdx.x >> 6);
    volatile LAS unsigned* bst = (volatile LAS unsigned*)(lds + LDS_MISC);
    if (threadIdx.x == 0) { bst[0] = 0u; bst[1] = 0u; }
    __syncthreads();
    const unsigned xcc = xb_xcc_id();
    float* out = args.out;
    const float* x_in = args.in[opaque_idx(I_X)];
#define TAB ((float*)(ws + WS_TAB))
#define XN ((bf16_t*)(ws + WS_XN))
#define Zb ((bf16_t*)(ws + WS_Z))
#define QM ((bf16_t*)(ws + WS_QM))
#define KVM ((bf16_t*)(ws + WS_KVM))
#define QA ((bf16_t*)(ws + WS_QA))
#define KA ((bf16_t*)(ws + WS_KA))
#define VA ((bf16_t*)(ws + WS_VA))
#define OA ((bf16_t*)(ws + WS_OA))
#define OB ((bf16_t*)(ws + WS_OB))
#define MIX ((bf16_t*)(ws + WS_MIX))
#define QC ((bf16_t*)(ws + WS_QC))
#define OC ((bf16_t*)(ws + WS_OC))
#define Ub ((bf16_t*)(ws + WS_U))
#define ACT ((bf16_t*)(ws + WS_ACT))

    for (int ph = args.ph_lo; ph < args.ph_hi; ++ph) {
        __attribute__((address_space(1))) unsigned char* wsg = (__attribute__((address_space(1))) unsigned char*)args.ws; asm volatile("" : "+s"(wsg));
        unsigned char* ws = (unsigned char*)wsg;
        int lane; asm volatile("v_mbcnt_lo_u32_b32 %0, -1, 0\n\tv_mbcnt_hi_u32_b32 %0, -1, %0" : "=v"(lane));
        const int gw = bx * 8 + wave, NGW = G * 8;
#define TIDX (wave * 64 + lane)
        const int pcode = (int)((args.prog[opaque_idx(ph >> 2)] >> ((ph & 3) * 8)) & 255u);
        if (pcode == 255) {
            LAS float* scr = (LAS float*)(lds + wave * 16384);
            constexpr int IT_IN = 16 * 69, IT_UQ = 6 * 24, IT_UKV = 4 * 32, IT_OUT = 16 * 32, IT_MQ = 16 * 16, IT_MKV = 16 * 32, IT_MO = 8 * 32, IT_UP = 16 * 176, IT_DN = 44 * 32;
            constexpr int IT_L = IT_IN + IT_UQ + IT_UKV + IT_OUT + IT_MQ + IT_MKV + IT_MO + IT_UP + IT_DN;
            for (int it = gw; it < 2 * IT_L; it += NGW) {
                const int l = it / IT_L; int r = it - l * IT_L;
                unsigned char* wb = ws + WS_W + (size_t)l * W_LAYER;
                if (r < IT_IN) { xpose_item(args.in[opaque_idx(I_WIN)] + (size_t)l * 1024 * IN_COLS, 1024, IN_COLS, (bf16_t*)(wb + W_IN), scr, r, lane, args.in[opaque_idx(I_MIXG)] + l * DM); continue; } r -= IT_IN;
                if (r < IT_UQ) { xpose_item(args.in[opaque_idx(I_WUQ)] + (size_t)l * 384 * 768, 384, 768, (bf16_t*)(wb + W_UQ), scr, r, lane); continue; } r -= IT_UQ;
                if (r < IT_UKV) { xpose_item(args.in[opaque_idx(I_WUKV)] + (size_t)l * 256 * 1024, 256, 1024, (bf16_t*)(wb + W_UKV), scr, r, lane); continue; } r -= IT_UKV;
                if (r < IT_OUT) { xpose_item(args.in[opaque_idx(I_WOUT)] + (size_t)l * 1024 * 1024, 1024, 1024, (bf16_t*)(wb + W_OUT), scr, r, lane, args.in[opaque_idx(I_GRPG)] + l * 1024); continue; } r -= IT_OUT;
                if (r < IT_MQ) { xpose_item(args.in[opaque_idx(I_MWQ)] + (size_t)l * 1024 * 512, 1024, 512, (bf16_t*)(wb + W_MQ), scr, r, lane, args.in[opaque_idx(I_MEMNG)] + l * DM); continue; } r -= IT_MQ;
                if (r < IT_MKV) { xpose_item(args.in[opaque_idx(I_MWKV)] + (size_t)l * 1024 * 1024, 1024, 1024, (bf16_t*)(wb + W_MKV), scr, r, lane); continue; } r -= IT_MKV;
                if (r < IT_MO) { xpose_item(args.in[opaque_idx(I_MWO)] + (size_t)l * 512 * 1024, 512, 1024, (bf16_t*)(wb + W_MO), scr, r, lane); continue; } r -= IT_MO;
                if (r < IT_UP) { xpose_item(args.in[opaque_idx(I_WUP)] + (size_t)l * 1024 * DFF2, 1024, DFF2, (bf16_t*)(wb + W_UP), scr, r, lane, args.in[opaque_idx(I_FFNG)] + l * DM, 1); continue; } r -= IT_UP;
                xpose_item(args.in[opaque_idx(I_WDN)] + (size_t)l * DFF * 1024, DFF, 1024, (bf16_t*)(wb + W_DN), scr, r, lane);
            }
            for (int i = bx * 512 + TIDX; i < 2 * 96 * 1024 / 8; i += G * 512) { const int l = i / (96 * 128), rr = i % (96 * 128);
                const unsigned z = opaque_zero();
                *(u32x4*)(ws + WS_W + (size_t)l * W_LAYER + W_IN + (size_t)IN_COLS * 1024 * 2 + (size_t)rr * 16) = (u32x4){z, z, z, z}; }
            if (bx == 0) { for (int i = TIDX; i < (int)(BAR_BYTES / 4); i += 512) ((unsigned*)(ws + WS_BAR))[i] = opaque_zero(); }
            for (int e = bx * 512 + TIDX; e < 192 * 8; e += G * 512) { const int p = e >> 3, j = e & 7; const int pos = p < 128 ? p : p - 128;
                const float inv = ((j & 1) ? 0.31622776601683794f : 1.0f) * ((j >> 1) == 0 ? 1.0f : (j >> 1) == 1 ? 0.1f : (j >> 1) == 2 ? 0.01f : 0.001f);
                float s, c; sincos_f((float)pos * inv, s, c); TAB[p * 16 + j] = c; TAB[p * 16 + 8 + j] = s; }
            {
                f32x4 nx[4];
                { const f32x4* xr = (const f32x4*)(x_in + (size_t)gw * DM) + lane;
#pragma unroll
                  for (int j = 0; j < 4; ++j) nx[j] = xr[64 * j]; }
                for (int m = gw; m < T; m += NGW) {
                    f32x4 v[4];
#pragma unroll
                    for (int j = 0; j < 4; ++j) v[j] = nx[j];
                    if (m + NGW < T) { const f32x4* xr = (const f32x4*)(x_in + (size_t)(m + NGW) * DM) + lane;
#pragma unroll
                        for (int j = 0; j < 4; ++j) nx[j] = xr[64 * j]; }
                    u32x2* o = (u32x2*)(XN + (size_t)m * DM) + lane; float ss = 0.f;
#pragma unroll
                    for (int j = 0; j < 4; ++j) { ss += (v[j].x * v[j].x + v[j].y * v[j].y) + (v[j].z * v[j].z + v[j].w * v[j].w); u32x2 w; w.x = pk2(v[j].x, v[j].y); w.y = pk2(v[j].z, v[j].w); o[64 * j] = w; }
                    ss = wave_sum(ss); if (lane == 0) ((float*)(ws + WS_RS))[m] = ss;
                }
            }
            for (int i = bx * 512 + TIDX; i < 9 * T / 4; i += G * 512) { const unsigned z = opaque_zero(); ((u32x4*)(ws + WS_RS) + T / 4)[i] = (u32x4){z, z, z, z}; }
            for (int m = gw; m < 2 * MEMT; m += NGW) { const int l = m / MEMT, rr = m % MEMT;
                norm_row(args.in[opaque_idx(I_MEM)] + (size_t)rr * DM, args.in[opaque_idx(I_MEMTOKG)] + l * DM, (bf16_t*)(ws + WS_MEMN) + (size_t)m * DM, lane); }
        } else {
            const int l = pcode >> 5, s = pcode & 31;
            unsigned char* wb = ws + WS_W + (size_t)l * W_LAYER;
            const int kind = (s == 1 || s == 3 || s == 7 || s == 9 || s == 11 || s == 13 || s == 15 || s == 17) ? 1 : 0;
            if (kind == 1 && EN_GEMM) {
                const int ng = (s == 1 || s == 3) ? 2 : 1;
#pragma unroll 1
                for (int gi = 0; gi < ng; ++gi) {
                    pg8::Gemm g{nullptr, nullptr, 0, 0, 0, 0, nullptr, nullptr, 256, 0}; pg8::EpiDesc e{0, 0, nullptr, nullptr, nullptr, nullptr, nullptr};
                    float* const RSB = (float*)(ws + WS_RS);
                    switch (s * 2 + gi) {
                    case 2: g = pg8::Gemm{XN, (const bf16_t*)(wb + W_IN), T, ZC, 1024, 1024, nullptr, nullptr, 256, 0}; e = pg8::EpiDesc{0, ZC, Zb, nullptr, RSB + (size_t)(l * 3 + 0) * T, nullptr, nullptr}; break;
                    case 3: g = pg8::Gemm{(const bf16_t*)(ws + WS_MEMN) + (size_t)l * MEMT * DM, (const bf16_t*)(wb + W_MKV), MEMT, 1024, 1024, 1024, nullptr, nullptr, 256, 0};
                            e = pg8::EpiDesc{0, 1024, (bf16_t*)(ws + WS_KVCR) + (size_t)l * MEMT * 1024, nullptr, nullptr, nullptr, nullptr}; break;
                    case 6: g = pg8::Gemm{Zb + OFF_CQ, (const bf16_t*)(wb + W_UQ), T, 768, 384, ZC, nullptr, nullptr, 256, 0}; e = pg8::EpiDesc{0, 768, QM, nullptr, nullptr, nullptr, nullptr}; break;
                    case 7: g = pg8::Gemm{Zb + OFF_CKV, (const bf16_t*)(wb + W_UKV), T, 1024, 256, ZC, nullptr, nullptr, 256, 0}; e = pg8::EpiDesc{0, 1024, KVM, nullptr, nullptr, nullptr, nullptr}; break;
                    case 14: g = pg8::Gemm{MIX, (const bf16_t*)(wb + W_OUT), T, 1024, 1024, 1024, RSB + (size_t)(6 + 2 * l) * T, RSB + (size_t)(7 + 2 * l) * T, 256, 0}; e = pg8::EpiDesc{1, 1024, out, (l == 0) ? x_in : (const float*)out, RSB + (size_t)(l * 3 + 1) * T, XN, RSB + (size_t)(7 + 2 * l) * T}; break;
                    case 18: g = pg8::Gemm{XN, (const bf16_t*)(wb + W_MQ), T, 512, 1024, 1024, nullptr, nullptr, 256, 0}; e = pg8::EpiDesc{0, 512, QC, nullptr, RSB + (size_t)(l * 3 + 1) * T, nullptr, nullptr}; break;
                    case 22: g = pg8::Gemm{OC, (const bf16_t*)(wb + W_MO), T, 1024, 512, 512, nullptr, nullptr, 256, 0}; e = pg8::EpiDesc{1, 1024, out, out, RSB + (size_t)(l * 3 + 2) * T, XN, nullptr}; break;
                    case 26: g = pg8::Gemm{XN - DM, (const bf16_t*)(wb + W_UP), 130 * 256, DFF2, 1024, 1024, nullptr, nullptr, 254, 0};
                             e = pg8::EpiDesc{2, DFF, ACT, args.in[opaque_idx(I_CONVW)] + (size_t)l * 3 * DFF2, RSB + (size_t)(l * 3 + 2) * T, nullptr, args.in[opaque_idx(I_CONVB)] + (size_t)l * DFF2}; break;
                    case 34: g = pg8::Gemm{ACT, (const bf16_t*)(wb + W_DN), T, 1024, DFF, DFF, nullptr, nullptr, 256, 0}; e = pg8::EpiDesc{1, 1024, out, out, RSB + (size_t)(l * 3 + 3) * T, (l == 0) ? XN : nullptr, nullptr}; break;
                    default: break;
                    }
                    LAS pg8::EpiDesc* dl = (LAS pg8::EpiDesc*)(lds + 131072 + 256);
                    __syncthreads();
                    LAS pg8::Gemm* gl = (LAS pg8::Gemm*)(lds + 131072 + 512);
                    if (wave == 0 && lane == 0) { gl->A = g.A; gl->Bt = g.Bt; gl->M = g.M; gl->N = g.N; gl->K = g.K; gl->lda = g.lda; gl->mida = g.mida; gl->midb = g.midb; gl->trows = g.trows; }
                    if (wave == 0 && lane == 0) { dl->mode = e.mode; dl->ldc = e.ldc; dl->dst = e.dst; dl->base = e.base; dl->rs = e.rs; dl->xb = e.xb; dl->rs2 = e.rs2; }
                    __syncthreads();
                    pg8::StaticOrder S; S.init(g.M, g.N, G, (s == 1 && gi == 1) ? ((bx + (G >> 1)) % G) : bx);
                    if (s == 13) { pg8::EpiConv E{dl}; pg8::gemm_phase<pg8::EpiConv, pg8::StaticOrder>(lds, gl, S, E, wave); }
                    else { pg8::EpiUni E{dl}; pg8::gemm_phase<pg8::EpiUni, pg8::StaticOrder>(lds, gl, S, E, wave); }
                }
            } else if (s == 2 && EN_P1) {
                const float* gq = args.in[opaque_idx(I_NAQG)] + l * 64; const float* gk = args.in[opaque_idx(I_NAKG)] + l * 64;
                const float* gcq = args.in[opaque_idx(I_QLATG)] + l * 384; const float* gckv = args.in[opaque_idx(I_KVLATG)] + l * 256;
                const unsigned z0 = opaque_zero();
                u32x4 nq, nk, n4, n5 = (u32x4){z0, z0, z0, z0};
                { const u32x4* zn = (const u32x4*)(Zb + (size_t)gw * ZC); nq = zn[lane]; nk = zn[64 + lane]; n4 = zn[192 + lane]; if (lane < 16) n5 = zn[256 + lane]; }
                for (int row = gw; row < T; row += NGW) {
                    u32x4* z = (u32x4*)(Zb + (size_t)row * ZC);
                    const u32x4 vq = nq, vk = nk, v4 = n4, v5 = n5;
                    if (row + NGW < T) { const u32x4* zn = (const u32x4*)(Zb + (size_t)(row + NGW) * ZC); nq = zn[lane]; nk = zn[64 + lane]; n4 = zn[192 + lane]; if (lane < 16) n5 = zn[256 + lane]; }
                    float fq[8], fk[8], f4[8], f5[8]; unpack8(vq, fq); unpack8(vk, fk); unpack8(v4, f4); unpack8(v5, f5);
                    float sq = 0.f, sk = 0.f, s4 = 0.f, s5 = 0.f;
#pragma unroll
                    for (int e = 0; e < 8; ++e) { sq += fq[e] * fq[e]; sk += fk[e] * fk[e]; s4 += f4[e] * f4[e]; s5 += f5[e] * f5[e]; }
                    sq += xorl<1>(sq); sq += xorl<2>(sq); sq += xorl<4>(sq);
                    sk += xorl<1>(sk); sk += xorl<2>(sk); sk += xorl<4>(sk);
                    const float scq = wave_sum(lane < 48 ? s4 : 0.f);
                    const float sckv = wave_sum((lane >= 48 ? s4 : 0.f) + (lane < 16 ? s5 : 0.f));
                    const float rq = (0.125f * LOG2E) / sqrtf(sq * (1.0f / 64.0f) + EPS), rk = 1.0f / sqrtf(sk * (1.0f / 64.0f) + EPS);
                    const float rcq = 1.0f / sqrtf(scq * (1.0f / 384.0f) + EPS), rckv = 1.0f / sqrtf(sckv * (1.0f / 256.0f) + EPS);
                    const int hc = (lane & 7) * 8;
                    const float* g4 = (lane < 48) ? (gcq + lane * 8) : (gckv + (lane - 48) * 8); const float r4 = (lane < 48) ? rcq : rckv;
                    const float* g5 = gckv + (16 + (lane & 15)) * 8;
#pragma unroll
                    for (int e = 0; e < 8; ++e) { fq[e] *= rq * gq[hc + e]; fk[e] *= rk * gk[hc + e]; f4[e] *= r4 * g4[e]; f5[e] *= rckv * g5[e]; }
                    z[lane] = pack8(fq); z[64 + lane] = pack8(fk); z[192 + lane] = pack8(f4); if (lane < 16) z[256 + lane] = pack8(f5);
                }
                const float* gmk = args.in[opaque_idx(I_MKG)] + l * 128;
                for (int row = gw; row < MEMT; row += NGW) {
                    const u32x4* src = (const u32x4*)((bf16_t*)(ws + WS_KVCR) + ((size_t)l * MEMT + row) * 1024);
                    const u32x4 vk = src[lane], vv = src[64 + lane];
                    float fk[8]; unpack8(vk, fk); float sk = 0.f;
#pragma unroll
                    for (int e = 0; e < 8; ++e) sk += fk[e] * fk[e];
                    sk += xorl<1>(sk); sk += xorl<2>(sk); sk += xorl<4>(sk); sk += xorl<8>(sk);
                    const float rk = 1.0f / sqrtf(sk * (1.0f / 128.0f) + EPS);
                    const int hc = (lane & 15) * 8, hd = lane >> 4, b = row >> 8, m = row & 255;
#pragma unroll
                    for (int e = 0; e < 8; ++e) fk[e] *= rk * gmk[hc + e];
                    const size_t dst = ((size_t)l * MEMT * 512) + (((size_t)(b * 4 + hd) * 256 + m) * 128 + hc);
                    *(u32x4*)((bf16_t*)(ws + WS_KC) + dst) = pack8(fk);
                    *(u32x4*)((bf16_t*)(ws + WS_VC) + dst) = vv;
                }
            } else if (s == 4 && EN_P2) {
                const float* gq = args.in[opaque_idx(I_MLAQG)] + l * 96; const float* gk = args.in[opaque_idx(I_MLAKG)] + l * 96;
                const float qsc = 0.10206207261596575f * LOG2E;
                for (int rep = 0; rep < REP_EW; ++rep)
                for (int idx = bx * 512 + TIDX; idx < T * 8; idx += G * 512) {
                    const int tok = idx >> 3, h = idx & 7, b = tok >> 13, sp = tok & 8191, prow = sp >> 6, pcol = sp & 63;
                    const float* tr = TAB + prow * 16; const float* tc = TAB + (128 + pcol) * 16;
                    const size_t dq = ((size_t)(b * 8 + h) * SEQ + sp) * 96;
                    {
                        const u32x4* srck = (const u32x4*)(KVM + (size_t)tok * 1024 + h * 128);
                        const u32x4* srcr = (const u32x4*)(Zb + (size_t)tok * ZC + OFF_KR);
                        u32x4 c[12]; float ss = 0.f;
#pragma unroll
                        for (int i = 0; i < 8; ++i) { c[i] = srck[i]; ss += sumsq8(c[i]); }
#pragma unroll
                        for (int i = 0; i < 4; ++i) { c[8 + i] = srcr[i]; ss += sumsq8(c[8 + i]); }
                        const float rs = 1.0f / sqrtf(ss * (1.0f / 96.0f) + EPS);
                        u32x4* dst = (u32x4*)(KA + dq);
#pragma unroll
                        for (int i = 0; i < 8; ++i) { float f[8]; unpack8(c[i], f);
#pragma unroll
                            for (int e = 0; e < 8; ++e) f[e] *= rs * gk[i * 8 + e];
                            dst[i] = pack8(f); }
#pragma unroll
                        for (int i = 0; i < 2; ++i) { float x1[8], x2[8], o1[8], o2[8]; unpack8(c[8 + i], x1); unpack8(c[10 + i], x2); const float* tt = i ? tc : tr;
#pragma unroll
                            for (int e = 0; e < 8; ++e) { const float a = x1[e] * rs * gk[64 + i * 8 + e], bb = x2[e] * rs * gk[80 + i * 8 + e]; const float cs = tt[e], sn = tt[8 + e];
                                o1[e] = a * cs - bb * sn; o2[e] = bb * cs + a * sn; }
                            dst[8 + i] = pack8(o1); dst[10 + i] = pack8(o2); }
                        u32x4* dv = (u32x4*)(VA + ((size_t)(b * 8 + h) * SEQ + sp) * 64);
#pragma unroll
                        for (int i = 0; i < 8; ++i) dv[i] = srck[8 + i];
                    }
                }
            } else if (s == 5 && EN_ATT) {
                if (EN_MLA) {
                    const float* gq = args.in[opaque_idx(I_MLAQG)] + l * 96; const float* gk = args.in[opaque_idx(I_MLAKG)] + l * 96;
                    float mq = fmaxf(fabsf(gq[lane]), lane < 32 ? fabsf(gq[64 + lane]) : 0.f), mk = fmaxf(fabsf(gk[lane]), lane < 32 ? fabsf(gk[64 + lane]) : 0.f);
                    mq = wave_max(mq); mk = wave_max(mk);
                    const float negm = -(9.797958971132712f * mq * mk * LOG2E);
                    for (int rep = 0; rep < REP_MLA; ++rep)
                    for (int i = 0;; ++i) {
                        int bh, qb;
                        if (G == 256) { if (i >= 4) break; bh = i * 8 + (bx & 7); qb = bx >> 3; }
                        else { const int u = bx + i * G; if (u >= 1024) break; bh = u >> 5; qb = u & 31; }
                        const int b = bh >> 3, h = bh & 7;
                        att::dense_unit<96, 64, true, true>(QM + ((size_t)b * SEQ + qb * 256) * 768 + h * 96, 768, KA + (size_t)bh * SEQ * 96, VA + (size_t)bh * SEQ * 64,
                                                       MIX + ((size_t)b * SEQ + qb * 256) * 1024 + 512 + h * 64, 1024, SEQ, negm, gq, 0.10206207261596575f * LOG2E, lds, wave, (float*)(ws + WS_RS) + (size_t)(7 + 2 * l) * T + (size_t)b * SEQ + qb * 256, TAB, qb * 256);
                    }
                }
                if (EN_NA) {
                    int lane; asm volatile("v_mbcnt_lo_u32_b32 %0, -1, 0\n\tv_mbcnt_hi_u32_b32 %0, -1, %0" : "=v"(lane));
                    const int h = wave;
                    LAS unsigned char* wl = lds + wave * 16384; LAS float* biasT = (LAS float*)(lds + 131072 + wave * 2048); LAS float* wsf = (LAS float*)(lds + 131072 + 16384 + wave * 256);
                    const float* rp = args.in[opaque_idx(I_RPB)] + ((size_t)l * 8 + h) * 15 * 31;
                    float bm = 0.f;
                    for (int i = lane; i < 15 * 32; i += 64) { const int dr = i >> 5, dc = i & 31; const float v = (dc < 31) ? rp[dr * 31 + dc] : 0.f; biasT[i] = v * LOG2E; bm = fmaxf(bm, fabsf(v)); }
                    bm = wave_max(bm);
                    const float* gq = args.in[opaque_idx(I_NAQG)] + l * 64; const float* gk = args.in[opaque_idx(I_NAKG)] + l * 64;
                    const float mq = wave_max(fabsf(gq[lane])), mk = wave_max(fabsf(gk[lane]));
                    const float negm = -((8.0f * mq * mk + bm) * LOG2E);
                    asm volatile("s_waitcnt lgkmcnt(0)" ::: "memory");
                    for (int rep = 0; rep < REP_NA; ++rep)
                    for (int u = bx; u < BATCH * 128; u += G) att::na_unit(u >> 7, u & 127, h, Zb, MIX, (float*)(ws + WS_RS) + (size_t)(6 + 2 * l) * T, biasT, negm, wl, wsf);
                }
            } else if (s == 10 && EN_CROSS) {
                const float* gq = args.in[opaque_idx(I_MQG)] + l * 128; const float* gk = args.in[opaque_idx(I_MKG)] + l * 128;
                const float mq = wave_max(fmaxf(fabsf(gq[lane]), fabsf(gq[64 + lane]))), mk = wave_max(fmaxf(fabsf(gk[lane]), fabsf(gk[64 + lane])));
                const float negm = -(11.313708498984761f * mq * mk * LOG2E);
                const float qsc = 0.08838834764831845f * LOG2E;
                const bf16_t* KCl = (const bf16_t*)(ws + WS_KC) + (size_t)l * MEMT * 512; const bf16_t* VCl = (const bf16_t*)(ws + WS_VC) + (size_t)l * MEMT * 512;
                for (int rep = 0; rep < REP_CROSS; ++rep)
                for (int u = bx; u < 512; u += G) { const int bhd = u >> 5, qb = u & 31, b = bhd >> 2, hd = bhd & 3;
                    att::dense_unit<128, 128, true>(QC + ((size_t)b * SEQ + qb * 256) * 512 + hd * 128, 512, KCl + (size_t)bhd * 256 * 128, VCl + (size_t)bhd * 256 * 128,
                                                    OC + ((size_t)b * SEQ + qb * 256) * 512 + hd * 128, 512, 256, negm, gq, qsc, lds, wave); }
            } else if ((s == 14 || s == 16) && EN_CONV) {
                const int hf = (s == 16);
                const float* cw = args.in[opaque_idx(I_CONVW)] + (size_t)l * 3 * DFF2; const float* cb = args.in[opaque_idx(I_CONVB)] + (size_t)l * DFF2;
                constexpr int RUN = 8, NCH = DFF / 8, NITEM = (TH / RUN) * NCH;
                for (int it = bx * 512 + TIDX; it < NITEM; it += G * 512) {
                    const int run = it / NCH, nc = it - run * NCH, n0 = nc * 8, t0 = run * RUN;
                    const int s0 = (hf * TH + t0) & (SEQ - 1);
                    const bf16_t* up = Ub + (size_t)t0 * DFF2 + n0;
                    const unsigned z0 = opaque_zero(); const u32x4 zero = (u32x4){z0, z0, z0, z0};
                    u32x4 rg[RUN + 2], rv[RUN + 2];
                    rg[0] = zero; rv[0] = zero; rg[RUN + 1] = zero; rv[RUN + 1] = zero;
                    if (s0 != 0) { rg[0] = *(const u32x4*)(up - DFF2); rv[0] = *(const u32x4*)(up - DFF2 + DFF); }
#pragma unroll
                    for (int i = 0; i < RUN; ++i) { rg[i + 1] = *(const u32x4*)(up + (size_t)i * DFF2); rv[i + 1] = *(const u32x4*)(up + (size_t)i * DFF2 + DFF); }
                    if (s0 + RUN - 1 != SEQ - 1) { rg[RUN + 1] = *(const u32x4*)(up + (size_t)RUN * DFF2); rv[RUN + 1] = *(const u32x4*)(up + (size_t)RUN * DFF2 + DFF); }
                    float w0g[8], w1g[8], w2g[8], bg[8], w0v[8], w1v[8], w2v[8], bv[8];
#pragma unroll
                    for (int e = 0; e < 8; ++e) { w0g[e] = cw[n0 + e]; w1g[e] = cw[DFF2 + n0 + e]; w2g[e] = cw[2 * DFF2 + n0 + e]; bg[e] = cb[n0 + e];
                        w0v[e] = cw[DFF + n0 + e]; w1v[e] = cw[DFF2 + DFF + n0 + e]; w2v[e] = cw[2 * DFF2 + DFF + n0 + e]; bv[e] = cb[DFF + n0 + e]; }
#pragma unroll
                    for (int i = 0; i < RUN; ++i) {
                        float a0[8], a1[8], a2[8], c0[8], c1[8], c2[8], o[8];
                        unpack8(rg[i], a0); unpack8(rg[i + 1], a1); unpack8(rg[i + 2], a2); unpack8(rv[i], c0); unpack8(rv[i + 1], c1); unpack8(rv[i + 2], c2);
#pragma unroll
                        for (int e = 0; e < 8; ++e) { const float gt = a0[e] * w0g[e] + a1[e] * w1g[e] + a2[e] * w2g[e] + bg[e]; const float vl = c0[e] * w0v[e] + c1[e] * w1v[e] + c2[e] * w2v[e] + bv[e];
                            o[e] = gt / (1.0f + __expf(-gt)) * vl; }
                        *(u32x4*)(ACT + (size_t)(t0 + i) * DFF + n0) = pack8(o);
                    }
                }
            }
        }
        if (ph + 1 < args.ph_hi) {
            if (ph == args.ph_lo) { cg::this_grid().sync();
                int ln3; asm volatile("v_mbcnt_lo_u32_b32 %0, -1, 0\n\tv_mbcnt_hi_u32_b32 %0, -1, %0" : "=v"(ln3));
                if (wave == 0 && ln3 == 0) (void)xb_add((unsigned*)(ws + WS_BAR) + XB_XCNT(xcc), 1u); }
            else { int ln2; asm volatile("v_mbcnt_lo_u32_b32 %0, -1, 0\n\tv_mbcnt_hi_u32_b32 %0, -1, %0" : "=v"(ln2));
                   xcd_barrier((unsigned*)(ws + WS_BAR), xcc, bst, wave == 0 && ln2 == 0); }
        }
    }
}

extern "C" void kernel_launch(void* const* d_in, const int* in_sizes, int n_in, void* d_out, int out_size, void* d_ws, size_t ws_size, hipStream_t stream) {
    static int grid = 0;
    if (grid == 0) {
        if (n_in != 27 || in_sizes[0] != T * DM || out_size != T * DM || ws_size < WS_END) { fprintf(stderr, "kernel_launch: unexpected shapes (n_in %d, ws %zu)\n", n_in, ws_size); grid = -1; return; }
        int dev = 0, cus = 0, per_cu = 0;
        hipGetDevice(&dev); hipDeviceGetAttribute(&cus, hipDeviceAttributeMultiprocessorCount, dev);
        if (hipFuncSetAttribute((const void*)mega_fwd, hipFuncAttributeMaxDynamicSharedMemorySize, LDS_BYTES) != hipSuccess) { fprintf(stderr, "kernel_launch: hipFuncSetAttribute failed\n"); grid = -1; return; }
        hipOccupancyMaxActiveBlocksPerMultiprocessor(&per_cu, (const void*)mega_fwd, 512, LDS_BYTES);
        (void)hipGetLastError();
        if (per_cu < 1) per_cu = 1;
        grid = cus * 1;
        if (grid <= 0) grid = 256;
    }
    if (grid < 0) return;
    Args a{};
    for (int i = 0; i < 27; ++i) a.in[i] = (const float*)d_in[i];
    a.out = (float*)d_out; a.ws = (unsigned char*)d_ws;
#ifndef PROBE_MASK
#define PROBE_MASK 0u
#endif
    static const int SEQ15[11] = {1, 2, 3, 4, 5, 7, 9, 10, 11, 13, 17};
    unsigned char pb[96]; int NPH = 0;
    for (int i = 0; i < 96; ++i) pb[i] = 0;
    pb[NPH++] = 255; if (PROBE_MASK & 1u) pb[NPH++] = 255;
    for (int l = 0; l < DEPTH; ++l) for (int i = 0; i < 11; ++i) { const int s = SEQ15[i]; pb[NPH++] = (unsigned char)(l * 32 + s); if ((PROBE_MASK >> s) & 1u) pb[NPH++] = (unsigned char)(l * 32 + s); }
    for (int i = 0; i < 24; ++i) a.prog[i] = (unsigned)pb[4 * i] | ((unsigned)pb[4 * i + 1] << 8) | ((unsigned)pb[4 * i + 2] << 16) | ((unsigned)pb[4 * i + 3] << 24);
#if MK_PER_PHASE
    for (int ph = 0; ph < NPH; ++ph) { a.ph_lo = ph; a.ph_hi = ph + 1; hipLaunchKernelGGL(mega_fwd, dim3(grid), dim3(512), LDS_BYTES, stream, a); }
#else
    a.ph_lo = 0; a.ph_hi = NPH;
    void* kargs[] = {&a};
    hipError_t e = hipLaunchCooperativeKernel((const void*)mega_fwd, dim3(grid), dim3(512), kargs, LDS_BYTES, stream);
    if (e != hipSuccess) fprintf(stderr, "kernel_launch: cooperative launch failed: %s (grid %d)\n", hipGetErrorString(e), grid);
#endif
}
```
